# Optimizing an MI355X kernel written in HIP

```python
import math
import jax, jax.numpy as jnp
from jax import lax
import numpy as np

D_MODEL = 1024
BATCH = 4
SEQ = 4096
DEPTH = 4

N_MIXERS = 3
EXPAND = 2
D_INNER = EXPAND * D_MODEL
NORM_EPS = 1e-6

GMLP_CHUNK = 128
GMLP_GROUPS = 8

S5_GROUP = 16
S5_STATE = 64
S5_GROUPS = D_INNER // S5_GROUP
S5_DT_MIN = 1e-3
S5_DT_MAX = 1e-1

MLA_HEADS = 16
MLA_NOPE = 128
MLA_ROPE = 64
MLA_V = D_INNER // MLA_HEADS
MLA_QK_DIM = MLA_NOPE + MLA_ROPE
MLA_Q_RANK = 384
MLA_KV_RANK = 128
MLA_SCALE = MLA_QK_DIM ** -0.5
ROPE_THETA = 10000.0
ATTN_QBLOCK = 128
NEG_INF = -1e30

kernel_name = "hybrid_gmlp_s5_mla_gated"


def _rmsnorm(x, g):
    xf = x.astype(jnp.float32)
    y = xf * lax.rsqrt(jnp.mean(xf * xf, axis=-1, keepdims=True) + NORM_EPS)
    return (y * g.astype(jnp.float32)).astype(x.dtype)


def _layernorm(x, g, b):
    xf = x.astype(jnp.float32)
    mu = jnp.mean(xf, axis=-1, keepdims=True)
    xc = xf - mu
    var = jnp.mean(xc * xc, axis=-1, keepdims=True)
    y = xc * lax.rsqrt(var + NORM_EPS) * g.astype(jnp.float32) + b.astype(jnp.float32)
    return y.astype(x.dtype)


def _rope(x, cos, sin):
    half = x.shape[-1] // 2
    x1 = x[..., :half].astype(jnp.float32)
    x2 = x[..., half:].astype(jnp.float32)
    return jnp.concatenate([x1 * cos - x2 * sin, x2 * cos + x1 * sin], axis=-1).astype(x.dtype)


def _gmlp_mixer(h, w_in, ln_g, ln_b, w_s, b_s, w_out):
    bsz, seq, _ = h.shape
    u, v, z = jnp.split(h @ w_in, 3, axis=-1)
    u = jax.nn.gelu(u)
    v = _layernorm(jax.nn.gelu(v), ln_g, ln_b)
    v = v.reshape(bsz, seq // GMLP_CHUNK, GMLP_CHUNK, GMLP_GROUPS, D_INNER // GMLP_GROUPS)
    causal = jnp.tril(jnp.ones((GMLP_CHUNK, GMLP_CHUNK), dtype=bool))
    w = jnp.where(causal[None], w_s, jnp.zeros((), w_s.dtype))
    s = jnp.einsum('gts,bcsgd->bctgd', w, v) + b_s.T[:, :, None]
    s = s.reshape(bsz, seq, D_INNER)
    return (u * s * jax.nn.silu(z)) @ w_out


def _s5_combine(left, right):
    a_l, b_l = left
    a_r, b_r = right
    return a_r * a_l, a_r * b_l + b_r


def _s5_mixer(h, w_in, a_re, a_im, log_step, b_re, b_im, c_re, c_im, d_skip, w_glu, b_glu, w_out):
    bsz, seq, _ = h.shape
    u, z = jnp.split(h @ w_in, 2, axis=-1)
    uf = u.astype(jnp.float32).reshape(bsz, seq, S5_GROUPS, S5_GROUP)
    lam = lax.complex(a_re.astype(jnp.float32), a_im.astype(jnp.float32))
    step = jnp.exp(log_step.astype(jnp.float32))[:, None]
    lam_bar = jnp.exp(lam * step)
    bmat = lax.complex(b_re.astype(jnp.float32), b_im.astype(jnp.float32))
    b_bar = ((lam_bar - 1.0) / lam)[..., None] * bmat
    bu = lax.complex(jnp.einsum('blgh,gph->lbgp', uf, jnp.real(b_bar)),
                     jnp.einsum('blgh,gph->lbgp', uf, jnp.imag(b_bar)))
    a_elems = jnp.broadcast_to(lam_bar, (seq, 1, S5_GROUPS, S5_STATE))
    _, xs = lax.associative_scan(_s5_combine, (a_elems, bu), axis=0)
    y = (jnp.einsum('lbgp,ghp->blgh', jnp.real(xs), c_re.astype(jnp.float32))
         - jnp.einsum('lbgp,ghp->blgh', jnp.imag(xs), c_im.astype(jnp.float32)))
    y = y + d_skip.astype(jnp.float32).reshape(S5_GROUPS, S5_GROUP) * uf
    y = jax.nn.gelu(y.reshape(bsz, seq, D_INNER)).astype(h.dtype)
    y = y * jax.nn.sigmoid(y @ w_glu + b_glu)
    return (y * jax.nn.silu(z)) @ w_out


def _mla_mixer(h, positions, w_in, q_norm_g, w_uq, kv_norm_g, w_ukv, w_out):
    bsz, seq, _ = h.shape
    c_q, c_kv, k_r, z = jnp.split(
        h @ w_in, [MLA_Q_RANK, MLA_Q_RANK + MLA_KV_RANK, MLA_Q_RANK + MLA_KV_RANK + MLA_ROPE], axis=-1)
    q = (_rmsnorm(c_q, q_norm_g) @ w_uq).reshape(bsz, seq, MLA_HEADS, MLA_QK_DIM)
    q_nope, q_rope = q[..., :MLA_NOPE], q[..., MLA_NOPE:]
    kv = (_rmsnorm(c_kv, kv_norm_g) @ w_ukv).reshape(bsz, seq, MLA_HEADS, MLA_NOPE + MLA_V)
    k_nope, v = kv[..., :MLA_NOPE], kv[..., MLA_NOPE:]
    inv_freq = ROPE_THETA ** (-jnp.arange(0, MLA_ROPE, 2, dtype=jnp.float32) / MLA_ROPE)
    ang = positions.astype(jnp.float32)[..., None] * inv_freq
    cos, sin = jnp.cos(ang), jnp.sin(ang)
    q_rope = _rope(q_rope, cos[:, :, None], sin[:, :, None])
    k_r = _rope(k_r, cos, sin)
    n_blk = seq // ATTN_QBLOCK

    def to_blocks(t):
        return t.reshape(bsz, n_blk, ATTN_QBLOCK, *t.shape[2:]).swapaxes(0, 1)

    kpos = jnp.arange(seq)

    def attend(args):
        qn_b, qr_b, blk = args
        s = (jnp.einsum('bqhd,bkhd->bhqk', qn_b, k_nope)
             + jnp.einsum('bqhd,bkd->bhqk', qr_b, k_r)).astype(jnp.float32) * MLA_SCALE
        qpos = blk * ATTN_QBLOCK + jnp.arange(ATTN_QBLOCK)
        s = jnp.where(kpos[None, :] <= qpos[:, None], s, NEG_INF)
        p = jax.nn.softmax(s, axis=-1).astype(v.dtype)
        return jnp.einsum('bhqk,bkhd->bqhd', p, v)

    o = lax.map(attend, (to_blocks(q_nope), to_blocks(q_rope), jnp.arange(n_blk)))
    o = o.swapaxes(0, 1).reshape(bsz, seq, MLA_HEADS * MLA_V)
    return (o * jax.nn.silu(z)) @ w_out


def _gain(key, n):
    return 1.0 + 0.02 * jax.random.normal(key, (n,), jnp.float32)


def _normal(key, shape, scale):
    return jax.random.normal(key, shape, jnp.float32) * scale


def _gmlp_params(key, p):
    k = jax.random.split(key, 7)
    return {
        p + 'norm_g': _gain(k[0], D_MODEL),
        p + 'w_in': _normal(k[1], (D_MODEL, 3 * D_INNER), D_MODEL ** -0.5),
        p + 'ln_g': _gain(k[2], D_INNER),
        p + 'ln_b': _normal(k[3], (D_INNER,), 0.02),
        p + 'w_s': _normal(k[4], (GMLP_GROUPS, GMLP_CHUNK, GMLP_CHUNK), GMLP_CHUNK ** -0.5),
        p + 'b_s': 1.0 + _normal(k[5], (GMLP_GROUPS, GMLP_CHUNK), 0.02),
        p + 'w_out': _normal(k[6], (D_INNER, D_MODEL), D_INNER ** -0.5),
    }


def _s5_params(key, p):
    k = jax.random.split(key, 14)
    n = jnp.arange(S5_STATE, dtype=jnp.float32)
    return {
        p + 'norm_g': _gain(k[0], D_MODEL),
        p + 'w_in': _normal(k[1], (D_MODEL, 2 * D_INNER), D_MODEL ** -0.5),
        p + 'a_re': -0.5 + _normal(k[2], (S5_GROUPS, S5_STATE), 0.01),
        p + 'a_im': math.pi * n[None, :] + _normal(k[3], (S5_GROUPS, S5_STATE), 0.01),
        p + 'log_step': jax.random.uniform(k[4], (S5_GROUPS,), jnp.float32,
                                           math.log(S5_DT_MIN), math.log(S5_DT_MAX)),
        p + 'b_re': _normal(k[5], (S5_GROUPS, S5_STATE, S5_GROUP), (2 * S5_GROUP) ** -0.5),
        p + 'b_im': _normal(k[6], (S5_GROUPS, S5_STATE, S5_GROUP), (2 * S5_GROUP) ** -0.5),
        p + 'c_re': _normal(k[7], (S5_GROUPS, S5_GROUP, S5_STATE), (2 * S5_STATE) ** -0.5),
        p + 'c_im': _normal(k[8], (S5_GROUPS, S5_GROUP, S5_STATE), (2 * S5_STATE) ** -0.5),
        p + 'd_skip': _normal(k[9], (D_INNER,), 1.0),
        p + 'w_glu': _normal(k[10], (D_INNER, D_INNER), D_INNER ** -0.5),
        p + 'b_glu': _normal(k[11], (D_INNER,), 0.02),
        p + 'w_out': _normal(k[12], (D_INNER, D_MODEL), D_INNER ** -0.5),
    }


def _mla_params(key, p):
    k = jax.random.split(key, 7)
    return {
        p + 'norm_g': _gain(k[0], D_MODEL),
        p + 'w_in': _normal(k[1], (D_MODEL, MLA_Q_RANK + MLA_KV_RANK + MLA_ROPE + D_INNER), D_MODEL ** -0.5),
        p + 'q_norm_g': _gain(k[2], MLA_Q_RANK),
        p + 'w_uq': _normal(k[3], (MLA_Q_RANK, MLA_HEADS * MLA_QK_DIM), MLA_Q_RANK ** -0.5),
        p + 'kv_norm_g': _gain(k[4], MLA_KV_RANK),
        p + 'w_ukv': _normal(k[5], (MLA_KV_RANK, MLA_HEADS * (MLA_NOPE + MLA_V)), MLA_KV_RANK ** -0.5),
        p + 'w_out': _normal(k[6], (MLA_HEADS * MLA_V, D_MODEL), D_INNER ** -0.5),
    }


def setup_inputs(seed: int = 0) -> dict:
    key = jax.random.key(seed)
    keys = jax.random.split(key, DEPTH + 4)
    x = jax.random.normal(keys[0], (BATCH, SEQ, D_MODEL), jnp.float32)
    offset = jax.random.randint(keys[1], (BATCH, 1), 0, 1024, dtype=jnp.int32)
    positions = offset + jnp.arange(SEQ, dtype=jnp.int32)[None, :]
    inputs = {'x': x, 'positions': positions}
    makers = (_gmlp_params, _s5_params, _mla_params)
    for i in range(DEPTH):
        inputs.update(makers[i % N_MIXERS](keys[2 + i], 'l%d_' % i))
    inputs['final_norm_g'] = _gain(keys[2 + DEPTH], D_MODEL)
    return inputs


def reference(x, positions,
              l0_norm_g, l0_w_in, l0_ln_g, l0_ln_b, l0_w_s, l0_b_s, l0_w_out,
              l1_norm_g, l1_w_in, l1_a_re, l1_a_im, l1_log_step, l1_b_re, l1_b_im, l1_c_re, l1_c_im,
              l1_d_skip, l1_w_glu, l1_b_glu, l1_w_out,
              l2_norm_g, l2_w_in, l2_q_norm_g, l2_w_uq, l2_kv_norm_g, l2_w_ukv, l2_w_out,
              l3_norm_g, l3_w_in, l3_ln_g, l3_ln_b, l3_w_s, l3_b_s, l3_w_out,
              final_norm_g):
    layer_params = (
        (l0_norm_g, (l0_w_in, l0_ln_g, l0_ln_b, l0_w_s, l0_b_s, l0_w_out)),
        (l1_norm_g, (l1_w_in, l1_a_re, l1_a_im, l1_log_step, l1_b_re, l1_b_im, l1_c_re, l1_c_im,
                     l1_d_skip, l1_w_glu, l1_b_glu, l1_w_out)),
        (l2_norm_g, (l2_w_in, l2_q_norm_g, l2_w_uq, l2_kv_norm_g, l2_w_ukv, l2_w_out)),
        (l3_norm_g, (l3_w_in, l3_ln_g, l3_ln_b, l3_w_s, l3_b_s, l3_w_out)),
    )
    h = x
    for i in range(DEPTH):
        norm_g, p = layer_params[i]
        hn = _rmsnorm(h, norm_g)
        kind = i % N_MIXERS
        if kind == 0:
            y = _gmlp_mixer(hn, *p)
        elif kind == 1:
            y = _s5_mixer(hn, *p)
        else:
            y = _mla_mixer(hn, positions, *p)
        h = h + y
    return _rmsnorm(h, final_norm_g)
```

```cpp
#include <hip/hip_runtime.h>
#include <hip/hip_cooperative_groups.h>
#include <stdint.h>
#include <stdio.h>
namespace cg = cooperative_groups;

typedef unsigned short bf16_t;
typedef __attribute__((ext_vector_type(8))) short bf16x8;
typedef __attribute__((ext_vector_type(16))) float f32x16;
typedef __attribute__((ext_vector_type(4))) unsigned u32x4;

#define DI_ __device__ __forceinline__
#define MFMA32(a, b, c) __builtin_amdgcn_mfma_f32_32x32x16_bf16((a), (b), (c), 0, 0, 0)

constexpr int T_TOK = 16384;
constexpr int DM = 1024;
constexpr int DIN = 2048;
constexpr int SEQ = 4096;
constexpr int LDS_STRIDE = 72;
constexpr int TILE_E = 128 * LDS_STRIDE;
constexpr int NT = 512;
constexpr int SMEM_MAIN = 2 * 512 * LDS_STRIDE * 2;
constexpr int SMEM_BYTES = SMEM_MAIN + 2048 + 16;
constexpr size_t BAR_OFF = 62ull << 20;
constexpr size_t MiB = 1ull << 20;

constexpr size_t W_OFF = 0, HB_OFF = 64 * MiB, B1_OFF = 96 * MiB, B2_OFF = 160 * MiB, B3_OFF = 224 * MiB;

struct Params {
  const float* in[37];
  float* out;
  unsigned char* ws;
};

__device__ const float INVF[32] = {
  1.000000000e+00f, 7.498942614e-01f, 5.623413324e-01f, 4.216965139e-01f, 3.162277639e-01f, 2.371373773e-01f, 1.778279394e-01f, 1.333521307e-01f,
  1.000000015e-01f, 7.498941571e-02f, 5.623413250e-02f, 4.216965288e-02f, 3.162277490e-02f, 2.371373773e-02f, 1.778279431e-02f, 1.333521493e-02f,
  9.999999776e-03f, 7.498941850e-03f, 5.623413250e-03f, 4.216964822e-03f, 3.162277630e-03f, 2.371373586e-03f, 1.778279431e-03f, 1.333521446e-03f,
  1.000000047e-03f, 7.498942432e-04f, 5.623413017e-04f, 4.216965172e-04f, 3.162277571e-04f, 2.371373703e-04f, 1.778279402e-04f, 1.333521504e-04f};

typedef float f32x2 __attribute__((ext_vector_type(2)));
typedef __bf16 bf16x2_t __attribute__((ext_vector_type(2)));
DI_ unsigned short f2bf(float x) { __bf16 h = (__bf16)x; return __builtin_bit_cast(unsigned short, h); }
DI_ float bf2f(unsigned short b) { return __uint_as_float(((unsigned)b) << 16); }
DI_ unsigned pack2(float a, float b) { f32x2 v; v[0] = a; v[1] = b; return __builtin_bit_cast(unsigned, __builtin_convertvector(v, bf16x2_t)); }
DI_ float sigmoidf_(float x) { return __builtin_amdgcn_rcpf(1.f + __expf(-x)); }
DI_ float siluf_(float x) { return x * sigmoidf_(x); }
DI_ float geluf_(float x) { float y = 1.5957691216057308f * (x + 0.044715f * x * x * x); return x * sigmoidf_(y); }
DI_ int crow(int i, int hf) { return (i & 3) + 8 * (i >> 2) + 4 * hf; }
DI_ float red32(float v) { v += __shfl_xor(v, 1); v += __shfl_xor(v, 2); v += __shfl_xor(v, 4); v += __shfl_xor(v, 8); v += __shfl_xor(v, 16); return v; }
DI_ float red64(float v) { v = red32(v); v += __shfl_xor(v, 32); return v; }
DI_ void sincos_red(float x, float* s, float* c) {
  double xd = (double)x;
  double k = rint(xd * 0.15915494309189535);
  float r = (float)(xd - k * 6.283185307179586);
  *s = __sinf(r); *c = __cosf(r);
}

struct GemmArgs {
  const bf16_t* A1; int lda1;
  const bf16_t* A2; int lda2; int kt_split;
  const bf16_t* Bt; int ldb; int nkt;
};

template <int WM, int WN, int MI, int NI>
DI_ void gemm_compute_sw(const bf16_t* As, const bf16_t* Bs, int wm, int wn, int r, int hf, f32x16 (&acc)[MI][NI]) {
  bf16x8 a[2][MI], b[2][NI];
  int ao[MI], ax[MI], bo[NI], bx[NI];
#pragma unroll
  for (int mi = 0; mi < MI; ++mi) { const int R = wm * MI * 32 + mi * 32 + r; ao[mi] = R * 64; ax[mi] = (R >> 1) & 7; }
#pragma unroll
  for (int ni = 0; ni < NI; ++ni) { const int R = wn * NI * 32 + ni * 32 + r; bo[ni] = R * 64; bx[ni] = (R >> 1) & 7; }
#pragma unroll
  for (int mi = 0; mi < MI; ++mi) a[0][mi] = *(const bf16x8*)(As + ao[mi] + ((hf ^ ax[mi]) * 8));
#pragma unroll
  for (int ni = 0; ni < NI; ++ni) b[0][ni] = *(const bf16x8*)(Bs + bo[ni] + ((hf ^ bx[ni]) * 8));
#pragma unroll
  for (int ks = 0; ks < 4; ++ks) {
    if (ks < 3) {
#pragma unroll
      for (int mi = 0; mi < MI; ++mi) a[(ks + 1) & 1][mi] = *(const bf16x8*)(As + ao[mi] + ((((ks + 1) * 2 + hf) ^ ax[mi]) * 8));
#pragma unroll
      for (int ni = 0; ni < NI; ++ni) b[(ks + 1) & 1][ni] = *(const bf16x8*)(Bs + bo[ni] + ((((ks + 1) * 2 + hf) ^ bx[ni]) * 8));
    }
#pragma unroll
    for (int mi = 0; mi < MI; ++mi)
#pragma unroll
      for (int ni = 0; ni < NI; ++ni) acc[mi][ni] = MFMA32(a[ks & 1][mi], b[ks & 1][ni], acc[mi][ni]);
    __builtin_amdgcn_sched_barrier(0);
  }
}

template <int WM, int WN, int MI, int NI>
DI_ void gemm_compute(const bf16_t* As, const bf16_t* Bs, int wm, int wn, int r, int hf, f32x16 (&acc)[MI][NI]) {
#pragma unroll
  for (int ks = 0; ks < 4; ++ks) {
    bf16x8 a[MI], b[NI];
#pragma unroll
    for (int mi = 0; mi < MI; ++mi) a[mi] = *(const bf16x8*)(As + (wm * MI * 32 + mi * 32 + r) * LDS_STRIDE + ks * 16 + hf * 8);
#pragma unroll
    for (int ni = 0; ni < NI; ++ni) b[ni] = *(const bf16x8*)(Bs + (wn * NI * 32 + ni * 32 + r) * LDS_STRIDE + ks * 16 + hf * 8);
#pragma unroll
    for (int mi = 0; mi < MI; ++mi)
#pragma unroll
      for (int ni = 0; ni < NI; ++ni) acc[mi][ni] = MFMA32(a[mi], b[ni], acc[mi][ni]);
  }
}

template <int WM, int WN, int MI, int NI, bool ZERO = true>
DI_ void gemm_mainloop(const GemmArgs& g, bf16_t* smem, f32x16 (&acc)[MI][NI]) {
  constexpr int BM = WM * MI * 32, BN = WN * NI * 32;
  constexpr int ATILE = BM * 64, STAGE = (BM + BN) * 64;
  constexpr int ACH = BM / 64, BCH = BN / 64, NPC = ACH + BCH, PPK = (NPC + 1) / 2;
  int tid_ = threadIdx.x; asm volatile("" : "+v"(tid_));
  const int tid = tid_, lane = tid & 63, w = tid >> 6, wm = w / WN, wn = w % WN;
  const int r = lane & 31, hf = lane >> 5;
  const int lrow = tid >> 3;
  const int gc = ((tid & 7) ^ ((lrow >> 1) & 7)) * 8;
  if (ZERO) {
#pragma unroll
    for (int mi = 0; mi < MI; ++mi)
#pragma unroll
      for (int ni = 0; ni < NI; ++ni)
#pragma unroll
        for (int i = 0; i < 16; ++i) acc[mi][ni][i] = 0.f;
  }
  const int key = (r >> 1) & 7;
  const int abase = (wm * MI * 32 + r) * 64, bbase = ATILE + (wn * NI * 32 + r) * 64;
  const int koff0 = ((0 + hf) ^ key) * 8, koff1 = ((2 + hf) ^ key) * 8, koff2 = ((4 + hf) ^ key) * 8, koff3 = ((6 + hf) ^ key) * 8;
  __syncthreads();
  {
    const bf16_t* a; int lda;
    if (0 < g.kt_split) { a = g.A1; lda = g.lda1; } else { a = g.A2; lda = g.lda2; }
    const int toffa = lrow * lda + gc, toffb = lrow * g.ldb + gc;
#pragma unroll
    for (int i = 0; i < ACH; ++i)
      __builtin_amdgcn_global_load_lds((const unsigned*)(a + (size_t)i * 64 * lda + toffa), (unsigned*)(smem + (i * NT + tid) * 8), 16, 0, 0);
#pragma unroll
    for (int i = 0; i < BCH; ++i)
      __builtin_amdgcn_global_load_lds((const unsigned*)(g.Bt + (size_t)i * 64 * g.ldb + toffb), (unsigned*)(smem + ATILE + (i * NT + tid) * 8), 16, 0, 0);
  }
  __syncthreads();
  bf16x8 a[2][MI], b[2][NI];
#pragma unroll
  for (int mi = 0; mi < MI; ++mi) a[0][mi] = *(const bf16x8*)(smem + abase + mi * 2048 + koff0);
#pragma unroll
  for (int ni = 0; ni < NI; ++ni) b[0][ni] = *(const bf16x8*)(smem + bbase + ni * 2048 + koff0);
  for (int kt = 0; kt < g.nkt; ++kt) {
    const bool more = (kt + 1 < g.nkt);
    const int k1 = kt + 1;
    const bf16_t* an; int ldan;
    if (k1 < g.kt_split) { an = g.A1 + k1 * 64; ldan = g.lda1; } else { an = g.A2 + (k1 - g.kt_split) * 64; ldan = g.lda2; }
    const bf16_t* bn = g.Bt + k1 * 64;
    const int toffa = lrow * ldan + gc, toffb = lrow * g.ldb + gc;
    bf16_t* Sn = smem + (k1 & 1) * STAGE;
    const bf16_t* Sc = smem + (kt & 1) * STAGE;
#pragma unroll
    for (int ks = 0; ks < 4; ++ks) {
      if (more) {
#pragma unroll
        for (int q = 0; q < PPK; ++q) {
          const int j = ks * PPK + q;
          if (j < ACH)
            __builtin_amdgcn_global_load_lds((const unsigned*)(an + (size_t)j * 64 * ldan + toffa), (unsigned*)(Sn + (j * NT + tid) * 8), 16, 0, 0);
          else if (j < NPC)
            __builtin_amdgcn_global_load_lds((const unsigned*)(bn + (size_t)(j - ACH) * 64 * g.ldb + toffb), (unsigned*)(Sn + ATILE + ((j - ACH) * NT + tid) * 8), 16, 0, 0);
        }
      }
      if (ks < 3) {
        const int ko = (ks == 0) ? koff1 : (ks == 1) ? koff2 : koff3;
#pragma unroll
        for (int mi = 0; mi < MI; ++mi) a[(ks + 1) & 1][mi] = *(const bf16x8*)(Sc + abase + mi * 2048 + ko);
#pragma unroll
        for (int ni = 0; ni < NI; ++ni) b[(ks + 1) & 1][ni] = *(const bf16x8*)(Sc + bbase + ni * 2048 + ko);
      } else {
        __syncthreads();
        if (more) {
#pragma unroll
          for (int mi = 0; mi < MI; ++mi) a[0][mi] = *(const bf16x8*)(Sn + abase + mi * 2048 + koff0);
#pragma unroll
          for (int ni = 0; ni < NI; ++ni) b[0][ni] = *(const bf16x8*)(Sn + bbase + ni * 2048 + koff0);
        }
      }
      __builtin_amdgcn_sched_barrier(0);
#pragma unroll
      for (int mi = 0; mi < MI; ++mi)
#pragma unroll
        for (int ni = 0; ni < NI; ++ni) acc[mi][ni] = MFMA32(a[ks & 1][mi], b[ks & 1][ni], acc[mi][ni]);
      __builtin_amdgcn_sched_barrier(0);
    }
  }
}

typedef __attribute__((ext_vector_type(4))) float f32x4;
#define MFMA16(a, b, c) __builtin_amdgcn_mfma_f32_16x16x32_bf16((a), (b), (c), 0, 0, 0)
template <int WM, int WN, int MT, int NQ>
DI_ void gemm_mainloop16(const GemmArgs& gr, bf16_t* smem, f32x4 (&acc)[MT][NQ]) {
  struct { const bf16_t* A1; int lda1; const bf16_t* A2; int lda2; int kt_split; const bf16_t* Bt; int ldb; int nkt; } g;
  g.A1 = gr.A1; g.lda1 = gr.lda1; g.A2 = gr.A2 ? gr.A2 : gr.A1; g.lda2 = gr.A2 ? gr.lda2 : gr.lda1; g.kt_split = gr.kt_split; g.Bt = gr.Bt; g.ldb = gr.ldb; g.nkt = gr.nkt;
  constexpr int BM = WM * MT * 16, BN = WN * NQ * 16;
  constexpr int ATILE = BM * 64, STAGE = (BM + BN) * 64;
  constexpr int ACH = BM / 64, BCH = BN / 64, NPC = ACH + BCH, PPK = (NPC + 1) / 2;
  int tid_ = threadIdx.x; asm volatile("" : "+v"(tid_));
  const int tid = tid_, lane = tid & 63, w = tid >> 6, wm = w / WN, wn = w % WN;
  const int r16 = lane & 15, quad = lane >> 4;
  const int lrow = tid >> 3;
  const int gc = ((tid & 7) ^ ((lrow >> 1) & 7)) * 8;
#pragma unroll
  for (int mt = 0; mt < MT; ++mt)
#pragma unroll
    for (int nq = 0; nq < NQ; ++nq)
#pragma unroll
      for (int j = 0; j < 4; ++j) acc[mt][nq][j] = 0.f;
  const int key = (r16 >> 1) & 7;
  const int abase = (wm * MT * 16 + r16) * 64, bbase = ATILE + (wn * NQ * 16 + r16) * 64;
  const int koff0 = ((0 + quad) ^ key) * 8, koff1 = ((4 + quad) ^ key) * 8;
  __syncthreads();
  {
    const bf16_t* a0 = (0 < g.kt_split) ? g.A1 : g.A2;
    const int lda0 = (0 < g.kt_split) ? g.lda1 : g.lda2;
    const int toffa = lrow * lda0 + gc, toffb = lrow * g.ldb + gc;
#pragma unroll
    for (int i = 0; i < ACH; ++i)
      __builtin_amdgcn_global_load_lds((const unsigned*)(a0 + (size_t)i * 64 * lda0 + toffa), (unsigned*)(smem + (i * NT + tid) * 8), 16, 0, 0);
#pragma unroll
    for (int i = 0; i < BCH; ++i)
      __builtin_amdgcn_global_load_lds((const unsigned*)(g.Bt + (size_t)i * 64 * g.ldb + toffb), (unsigned*)(smem + ATILE + (i * NT + tid) * 8), 16, 0, 0);
  }
  __syncthreads();
#pragma unroll 1
  for (int kt = 0; kt < g.nkt; ++kt) {
    const bool more = (kt + 1 < g.nkt);
    const int k1 = kt + 1;
    const bool first = k1 < g.kt_split;
    const bf16_t* an = (first ? g.A1 : g.A2) + (first ? k1 : k1 - g.kt_split) * 64;
    const int ldan = first ? g.lda1 : g.lda2;
    const bf16_t* bn = g.Bt + k1 * 64;
    const int toffa = lrow * ldan + gc, toffb = lrow * g.ldb + gc;
    bf16_t* Sn = smem + (k1 & 1) * STAGE;
    const bf16_t* Sc = smem + (kt & 1) * STAGE;
    __builtin_amdgcn_iglp_opt(0);
#pragma unroll
    for (int ks = 0; ks < 2; ++ks) {
      if (more) {
#pragma unroll
        for (int q = 0; q < PPK; ++q) {
          const int j = ks * PPK + q;
          if (j < ACH)
            __builtin_amdgcn_global_load_lds((const unsigned*)(an + (size_t)j * 64 * ldan + toffa), (unsigned*)(Sn + (j * NT + tid) * 8), 16, 0, 0);
          else if (j < NPC)
            __builtin_amdgcn_global_load_lds((const unsigned*)(bn + (size_t)(j - ACH) * 64 * g.ldb + toffb), (unsigned*)(Sn + ATILE + ((j - ACH) * NT + tid) * 8), 16, 0, 0);
        }
      }
      const int ko = ks ? koff1 : koff0;
      bf16x8 a[MT], b[NQ];
#pragma unroll
      for (int mt = 0; mt < MT; ++mt) a[mt] = *(const bf16x8*)(Sc + abase + mt * 1024 + ko);
#pragma unroll
      for (int nq = 0; nq < NQ; ++nq) b[nq] = *(const bf16x8*)(Sc + bbase + nq * 1024 + ko);
#pragma unroll
      for (int mt = 0; mt < MT; ++mt)
#pragma unroll
        for (int nq = 0; nq < NQ; ++nq) acc[mt][nq] = MFMA16(a[mt], b[nq], acc[mt][nq]);
    }
    __syncthreads();
  }
}

template <int WM, int WN, int MT, int NQ>
DI_ void gemm_mainloop16s(const GemmArgs& gr, bf16_t* smem, f32x4 (&acc)[MT][NQ]) {
  struct { const bf16_t* A1; int lda1; const bf16_t* A2; int lda2; int kt_split; const bf16_t* Bt; int ldb; int nkt; } g;
  g.A1 = gr.A1; g.lda1 = gr.lda1; g.A2 = gr.A2 ? gr.A2 : gr.A1; g.lda2 = gr.A2 ? gr.lda2 : gr.lda1; g.kt_split = gr.kt_split; g.Bt = gr.Bt; g.ldb = gr.ldb; g.nkt = gr.nkt;
  constexpr int BM = WM * MT * 16, BN = WN * NQ * 16;
  constexpr int ATILE = BM * 64, STAGE = (BM + BN) * 64;
  constexpr int ACH = BM / 64, BCH = BN / 64, NPC = ACH + BCH, PPK = (NPC + 1) / 2;
  int tid_ = threadIdx.x; asm volatile("" : "+v"(tid_));
  const int tid = tid_, lane = tid & 63, w = tid >> 6, wm = w / WN, wn = w % WN;
  const int r16 = lane & 15, quad = lane >> 4;
  const int lrow = tid >> 3;
  const int gc = ((tid & 7) ^ ((lrow >> 1) & 7)) * 8;
#pragma unroll
  for (int mt = 0; mt < MT; ++mt)
#pragma unroll
    for (int nq = 0; nq < NQ; ++nq)
#pragma unroll
      for (int j = 0; j < 4; ++j) acc[mt][nq][j] = 0.f;
  const int key = (r16 >> 1) & 7;
  const int abase = (wm * MT * 16 + r16) * 64, bbase = ATILE + (wn * NQ * 16 + r16) * 64;
  const int koff0 = ((0 + quad) ^ key) * 8, koff1 = ((4 + quad) ^ key) * 8;
  __syncthreads();
  {
    const bf16_t* a0 = (0 < g.kt_split) ? g.A1 : g.A2;
    const int lda0 = (0 < g.kt_split) ? g.lda1 : g.lda2;
    const int toffa = lrow * lda0 + gc, toffb = lrow * g.ldb + gc;
#pragma unroll
    for (int i = 0; i < ACH; ++i)
      __builtin_amdgcn_global_load_lds((const unsigned*)(a0 + (size_t)i * 64 * lda0 + toffa), (unsigned*)(smem + (i * NT + tid) * 8), 16, 0, 0);
#pragma unroll
    for (int i = 0; i < BCH; ++i)
      __builtin_amdgcn_global_load_lds((const unsigned*)(g.Bt + (size_t)i * 64 * g.ldb + toffb), (unsigned*)(smem + ATILE + (i * NT + tid) * 8), 16, 0, 0);
  }
  __syncthreads();
#pragma unroll 1
  for (int kt = 0; kt < g.nkt; ++kt) {
    const bool more = (kt + 1 < g.nkt);
    const int k1 = kt + 1;
    const bool first = k1 < g.kt_split;
    const bf16_t* an = (first ? g.A1 : g.A2) + (first ? k1 : k1 - g.kt_split) * 64;
    const int ldan = first ? g.lda1 : g.lda2;
    const bf16_t* bn = g.Bt + k1 * 64;
    const int toffa = lrow * ldan + gc, toffb = lrow * g.ldb + gc;
    bf16_t* Sn = smem + (k1 & 1) * STAGE;
    const bf16_t* Sc = smem + (kt & 1) * STAGE;
#pragma unroll
    for (int ks = 0; ks < 2; ++ks) {
      if (more) {
#pragma unroll
        for (int q = 0; q < PPK; ++q) {
          const int j = ks * PPK + q;
          if (j < ACH)
            __builtin_amdgcn_global_load_lds((const unsigned*)(an + (size_t)j * 64 * ldan + toffa), (unsigned*)(Sn + (j * NT + tid) * 8), 16, 0, 0);
          else if (j < NPC)
            __builtin_amdgcn_global_load_lds((const unsigned*)(bn + (size_t)(j - ACH) * 64 * g.ldb + toffb), (unsigned*)(Sn + ATILE + ((j - ACH) * NT + tid) * 8), 16, 0, 0);
        }
      }
      const int ko = ks ? koff1 : koff0;
      bf16x8 a[MT], b[NQ];
#pragma unroll
      for (int mt = 0; mt < MT; ++mt) a[mt] = *(const bf16x8*)(Sc + abase + mt * 1024 + ko);
#pragma unroll
      for (int nq = 0; nq < NQ; ++nq) b[nq] = *(const bf16x8*)(Sc + bbase + nq * 1024 + ko);
#pragma unroll
      for (int mt = 0; mt < MT; ++mt)
#pragma unroll
        for (int nq = 0; nq < NQ; ++nq) acc[mt][nq] = MFMA16(a[mt], b[nq], acc[mt][nq]);
      __builtin_amdgcn_sched_barrier(0);
    }
    __syncthreads();
  }
}

template <int ROWS> DI_ bf16_t* wave_stage(bf16_t* smem, int w) { return smem + w * ROWS * LDS_STRIDE; }
DI_ void stage_sync() { asm volatile("s_waitcnt lgkmcnt(0)" ::: "memory"); __builtin_amdgcn_wave_barrier(); }
template <int ROWS, int COLS> DI_ void stage_flush(const bf16_t* st, bf16_t* out, size_t ld, int lane) {
  constexpr int CPR = COLS / 8, RPI = 64 / CPR;
  stage_sync();
#pragma unroll 4
  for (int it = 0; it < ROWS / RPI; ++it) {
    const int row = it * RPI + lane / CPR, ch = lane % CPR;
    const uint4 v = *(const uint4*)(st + row * LDS_STRIDE + ch * 8);
    *(uint4*)(out + (size_t)row * ld + ch * 8) = v;
  }
  stage_sync();
}

template <int ROWS, int COLS> DI_ void stage_load(bf16_t* st, const bf16_t* in, size_t ld, int lane) {
  constexpr int CPR = COLS / 8, RPI = 64 / CPR;
#pragma unroll 4
  for (int it = 0; it < ROWS / RPI; ++it) {
    const int row = it * RPI + lane / CPR, ch = lane % CPR;
    const uint4 v = *(const uint4*)(in + (size_t)row * ld + ch * 8);
    *(uint4*)(st + row * LDS_STRIDE + ch * 8) = v;
  }
  stage_sync();
}
template <int ROWS, class F> DI_ void stage_rowstats(const bf16_t* st, int lane, F f) {
  stage_sync();
#pragma unroll 2
  for (int it = 0; it < ROWS / 8; ++it) {
    const int row = it * 8 + (lane >> 3), ch = lane & 7;
    const uint4 v = *(const uint4*)(st + row * LDS_STRIDE + ch * 8);
    const unsigned u[4] = {v.x, v.y, v.z, v.w};
    float s1 = 0.f, s2 = 0.f;
#pragma unroll
    for (int j = 0; j < 4; ++j) {
      const float a = __uint_as_float(u[j] << 16), b = __uint_as_float(u[j] & 0xffff0000u);
      s1 += a + b; s2 += a * a + b * b;
    }
    s1 += __shfl_xor(s1, 1); s2 += __shfl_xor(s2, 1);
    s1 += __shfl_xor(s1, 2); s2 += __shfl_xor(s2, 2);
    s1 += __shfl_xor(s1, 4); s2 += __shfl_xor(s2, 4);
    if (ch == 0) f(row, s1, s2);
  }
}

#define TILE_IDS() int tid_ = threadIdx.x; asm volatile("" : "+v"(tid_)); const int tid = tid_, lane = tid & 63, w = tid >> 6, r = lane & 31, hf = lane >> 5; (void)tid; (void)w; (void)r; (void)hf;
#define CFG_A() constexpr int WM = 2, WN = 4, MI = 4, NI = 2; const int wm = w / WN, wn = w % WN; (void)wm; (void)wn;
#define CFG_B() constexpr int WM = 4, WN = 2, MI = 2, NI = 2; const int wm = w / WN, wn = w % WN; (void)wm; (void)wn;
#define CFG_A16() constexpr int WM = 2, WN = 4, MT = 8, NQ = 4; const int wm = w / WN, wn = w % WN, r16 = lane & 15, quad = lane >> 4; (void)wm; (void)wn; (void)r16; (void)quad;
#define CFG_B16() constexpr int WM = 4, WN = 2, MT = 4, NQ = 4; const int wm = w / WN, wn = w % WN, r16 = lane & 15, quad = lane >> 4; (void)wm; (void)wn; (void)r16; (void)quad;
#define CFG_C() constexpr int WM = 2, WN = 4, MI = 2, NI = 2; const int wm = w / WN, wn = w % WN; (void)wm; (void)wn;

DI_ void rownorm_phase(const float* src, bf16_t* dst) {
  const int lane = threadIdx.x & 63;
  const int gw = blockIdx.x * 8 + (threadIdx.x >> 6), nw = gridDim.x * 8;
  for (int rr = gw; rr < T_TOK; rr += nw) {
    const int row = (gridDim.x == 256) ? ((((rr >> 3) & 7) + 8 * (rr >> 11)) << 8) + (((rr >> 6) & 31) << 3) + (rr & 7) : rr;
    const float4* s4 = (const float4*)(src + (size_t)row * DM);
    float4 v[4]; float ss = 0.f;
#pragma unroll
    for (int i = 0; i < 4; ++i) { v[i] = s4[lane + i * 64]; ss += v[i].x * v[i].x + v[i].y * v[i].y + v[i].z * v[i].z + v[i].w * v[i].w; }
    ss = red64(ss);
    const float rs = rsqrtf(ss * (1.f / 1024.f) + 1e-6f);
#pragma unroll
    for (int i = 0; i < 4; ++i) {
      uint2 o; o.x = pack2(v[i].x * rs, v[i].y * rs); o.y = pack2(v[i].z * rs, v[i].w * rs);
      *(uint2*)(dst + (size_t)row * DM + (lane + i * 64) * 4) = o;
    }
  }
}

DI_ void finalnorm_phase(float* h, const float* gain) {
  const int lane = threadIdx.x & 63;
  const int gw = blockIdx.x * 8 + (threadIdx.x >> 6), nw = gridDim.x * 8;
  for (int rr = gw; rr < T_TOK; rr += nw) {
    const int row = (gridDim.x == 256) ? ((((rr >> 3) & 7) + 8 * (rr >> 11)) << 8) + (((rr >> 6) & 31) << 3) + (rr & 7) : rr;
    float4* s4 = (float4*)(h + (size_t)row * DM);
    const float4* g4 = (const float4*)gain;
    float4 v[4]; float ss = 0.f;
#pragma unroll
    for (int i = 0; i < 4; ++i) { v[i] = s4[lane + i * 64]; ss += v[i].x * v[i].x + v[i].y * v[i].y + v[i].z * v[i].z + v[i].w * v[i].w; }
    ss = red64(ss);
    const float rs = rsqrtf(ss * (1.f / 1024.f) + 1e-6f);
#pragma unroll
    for (int i = 0; i < 4; ++i) {
      float4 g = g4[lane + i * 64];
      float4 o; o.x = v[i].x * rs * g.x; o.y = v[i].y * rs * g.y; o.z = v[i].z * rs * g.z; o.w = v[i].w * rs * g.w;
      s4[lane + i * 64] = o;
    }
  }
}

enum { MAP_IDENT = 0, MAP_GMLP = 1, MAP_MLA = 2, MAP_UV = 3 };
template <int MAP> DI_ int colmap(int n) {
  if (MAP == MAP_IDENT) return n;
  if (MAP == MAP_GMLP) {
    if (n < 4096) { int wt = n >> 6, rr = n & 63; int ch = wt * 32 + (rr & 31); return (rr < 32) ? ch : 4096 + ch; }
    return 2048 + (n - 4096);
  }
  if (MAP == MAP_MLA) { if (n < 576) return n; if (n < 640 || n >= 2688) return -1; return n - 64; }
    return (n >> 7) * 256 + 128 + (n & 127);
}
template <int MAP> DI_ void convT_phase(const float* src, int K, int Nsrc, int Ndst, const float* gain, bf16_t* dst, float* tile) {
  const int tx = threadIdx.x & 63, ty = threadIdx.x >> 6;
  const int nkb = K >> 7, ntiles = nkb * (Ndst >> 6);
  for (int t = blockIdx.x; t < ntiles; t += gridDim.x) {
    const int kb = t % nkb, nb = t / nkb, k0 = kb * 128, n0 = nb * 64;
    const int sc = colmap<MAP>(n0 + tx);
    __syncthreads();
#pragma unroll
    for (int q = 0; q < 16; ++q) {
      const int kk = ty + q * 8;
      float v = (sc >= 0) ? src[(size_t)(k0 + kk) * Nsrc + sc] : 0.f;
      if (gain) v *= gain[k0 + kk];
      tile[kk * 65 + tx] = v;
    }
    __syncthreads();
#pragma unroll
    for (int q = 0; q < 8; ++q) {
      const int nn = ty + q * 8;
      const unsigned o = pack2(tile[(2 * tx) * 65 + nn], tile[(2 * tx + 1) * 65 + nn]);
      *(unsigned*)(dst + (size_t)(n0 + nn) * K + k0 + 2 * tx) = o;
    }
  }
}

DI_ void gmlp_in_phase(const bf16_t* HB, const bf16_t* WinT, bf16_t* UZ, bf16_t* VgT, float* vstat, bf16_t* smem) {
  TILE_IDS(); CFG_A16();
  for (int t = blockIdx.x; t < 64 * 24; t += gridDim.x) {
    const int q_ = t >> 3, mt_ = (t & 7) + 8 * (q_ & 7), nt = 4 * (q_ >> 5) + ((q_ >> 3) & 3);
    GemmArgs g{HB + (size_t)mt_ * 256 * DM, DM, nullptr, 0, 1 << 30, WinT + (size_t)nt * 256 * DM, DM, 16};
    f32x4 acc[MT][NQ];
    gemm_mainloop16<WM, WN, MT, NQ>(g, smem, acc);
    const int cb = nt * 4 + wn;
    bf16_t* st = wave_stage<128>(smem, w);
    if (cb < 64) {
#pragma unroll
      for (int mt = 0; mt < MT; ++mt)
#pragma unroll
        for (int nq = 0; nq < 2; ++nq)
#pragma unroll
          for (int j = 0; j < 4; ++j)
            st[(mt * 16 + quad * 4 + j) * LDS_STRIDE + nq * 16 + r16] = f2bf(geluf_(acc[mt][nq][j]) * siluf_(acc[mt][nq + 2][j]));
      stage_flush<128, 32>(st, UZ + (size_t)(mt_ * 256 + wm * 128) * DIN + cb * 32, DIN, lane);
    } else {
      const int cbv = cb - 64;
#pragma unroll
      for (int mt = 0; mt < MT; ++mt)
#pragma unroll
        for (int nq = 0; nq < NQ; ++nq) {
          const int d = cbv * 64 + nq * 16 + r16;
          const float v0 = geluf_(acc[mt][nq][0]), v1 = geluf_(acc[mt][nq][1]), v2 = geluf_(acc[mt][nq][2]), v3 = geluf_(acc[mt][nq][3]);
          uint2 o; o.x = pack2(v0, v1); o.y = pack2(v2, v3);
          *(uint2*)(VgT + ((size_t)(mt_ * 2 + wm) * DIN + d) * 128 + mt * 16 + quad * 4) = o;
          bf16_t* sp = st + (mt * 16 + quad * 4) * LDS_STRIDE + nq * 16 + r16;
          sp[0] = (bf16_t)(o.x & 0xffffu); sp[LDS_STRIDE] = (bf16_t)(o.x >> 16);
          sp[2 * LDS_STRIDE] = (bf16_t)(o.y & 0xffffu); sp[3 * LDS_STRIDE] = (bf16_t)(o.y >> 16);
        }
      const int rowg = mt_ * 256 + wm * 128;
      stage_rowstats<128>(st, lane, [&](int row, float s1, float s2) {
        float2 o; o.x = s1; o.y = s2;
        *(float2*)(vstat + ((size_t)(rowg + row) * 32 + cbv) * 2) = o;
      });
      stage_sync();
    }
  }
}

DI_ void gmlp_gate_phase(const float* w_s, const float* b_s, const float* ln_g, const float* ln_b,
                         const bf16_t* VgT, const float* vstat, bf16_t* UZ, bf16_t* smem) {
  TILE_IDS(); CFG_C();
  constexpr int ATILE = 128 * LDS_STRIDE, STAGE = 384 * LDS_STRIDE;
  float* ext = (float*)((unsigned char*)smem + SMEM_MAIN);
  for (int item = blockIdx.x; item < 1024; item += gridDim.x) {
    const int xk = item >> 3, g = xk & 7, chunk = (((item & 7) + 8 * (xk >> 4)) << 1) + ((xk >> 3) & 1);
    __syncthreads();
    if (tid < 128) {
      const float2* ps = (const float2*)(vstat + (size_t)(chunk * 128 + tid) * 64);
      float s1 = 0.f, s2 = 0.f;
      for (int j = 0; j < 32; ++j) { float2 v = ps[j]; s1 += v.x; s2 += v.y; }
      const float mu = s1 * (1.f / 2048.f);
      const float var = fmaxf(s2 * (1.f / 2048.f) - mu * mu, 0.f);
      ext[tid] = mu; ext[128 + tid] = rsqrtf(var + 1e-6f);
    }
    __syncthreads();
    {
      const int tp = tid >> 2, q = tid & 3;
      const float4* wrow = (const float4*)(w_s + (size_t)(g * 128 + tp) * 128 + q * 32);
      float r0 = 0.f, r1 = 0.f;
#pragma unroll 1
      for (int j8 = 0; j8 < 4; ++j8) {
        const float4 wa = wrow[j8 * 2], wb = wrow[j8 * 2 + 1];
        const float wv[8] = {wa.x, wa.y, wa.z, wa.w, wb.x, wb.y, wb.z, wb.w};
        float sc[8];
#pragma unroll
        for (int j = 0; j < 8; ++j) {
          const int tk = q * 32 + j8 * 8 + j;
          const float wm_ = (tk <= tp) ? wv[j] : 0.f;
          r0 += wm_;
          sc[j] = bf2f(f2bf(wm_ * ext[128 + tk]));
          r1 += sc[j] * ext[tk];
        }
        uint4 o; o.x = pack2(sc[0], sc[1]); o.y = pack2(sc[2], sc[3]); o.z = pack2(sc[4], sc[5]); o.w = pack2(sc[6], sc[7]);
        const int tk0 = q * 32 + j8 * 8;
        *(uint4*)(smem + (tk0 >> 6) * STAGE + tp * LDS_STRIDE + (tk0 & 63)) = o;
      }
      r0 += __shfl_xor(r0, 1); r0 += __shfl_xor(r0, 2);
      r1 += __shfl_xor(r1, 1); r1 += __shfl_xor(r1, 2);
      if (q == 0) { ext[256 + tp] = r0; ext[384 + tp] = r1; }
    }
#pragma unroll 2
    for (int i = 0; i < 8; ++i) {
      const int c = tid + i * NT, d = c >> 4, kc = c & 15;
      uint4 v = *(const uint4*)(VgT + ((size_t)chunk * DIN + g * 256 + d) * 128 + kc * 8);
      *(uint4*)(smem + (kc >> 3) * STAGE + ATILE + d * LDS_STRIDE + (kc & 7) * 8) = v;
    }
    __syncthreads();
    f32x16 acc[MI][NI];
#pragma unroll
    for (int mi = 0; mi < MI; ++mi)
#pragma unroll
      for (int ni = 0; ni < NI; ++ni)
#pragma unroll
        for (int i = 0; i < 16; ++i) acc[mi][ni][i] = 0.f;
    gemm_compute<WM, WN, MI, NI>(smem, smem + ATILE, wm, wn, r, hf, acc);
    gemm_compute<WM, WN, MI, NI>(smem + STAGE, smem + STAGE + ATILE, wm, wn, r, hf, acc);
    __syncthreads();
    {
      bf16_t* st = wave_stage<64>(smem, w);
      bf16_t* gp = UZ + (size_t)(chunk * 128 + wm * 64) * DIN + g * 256 + wn * 64;
      stage_load<64, 64>(st, gp, DIN, lane);
#pragma unroll
      for (int ni = 0; ni < NI; ++ni) {
        const int ch = g * 256 + wn * 64 + ni * 32 + r;
        const float lg = ln_g[ch], lb = ln_b[ch];
#pragma unroll
        for (int mi = 0; mi < MI; ++mi)
#pragma unroll
          for (int i = 0; i < 16; ++i) {
            const int tp = wm * 64 + mi * 32 + crow(i, hf);
            const float sv = lg * (acc[mi][ni][i] - ext[384 + tp]) + lb * ext[256 + tp] + b_s[g * 128 + tp];
            bf16_t* pz = st + (mi * 32 + crow(i, hf)) * LDS_STRIDE + ni * 32 + r;
            *pz = f2bf(bf2f(*pz) * sv);
            if (i == 15) asm volatile("" ::: "memory");
          }
      }
      stage_flush<64, 64>(st, gp, DIN, lane);
    }
  }
}

DI_ void out_phase(const bf16_t* A, const bf16_t* WoutT, const float* hin, float* hout, bf16_t* smem) {
  TILE_IDS();
  constexpr int WM = 2, WN = 4, MT = 8, NQ = 4;
  const int wm = w / WN, wn = w % WN, r16 = lane & 15, quad = lane >> 4;
  for (int t = blockIdx.x; t < 64 * 4; t += gridDim.x) {
    const int mt_ = (t & 7) + 8 * (t >> 5), nt = (t >> 3) & 3;
    GemmArgs g{A + (size_t)mt_ * 256 * DIN, DIN, nullptr, 0, 1 << 30, WoutT + (size_t)nt * 256 * DIN, DIN, 32};
    f32x4 acc[MT][NQ];
    gemm_mainloop16<WM, WN, MT, NQ>(g, smem, acc);
#pragma unroll
    for (int mt = 0; mt < MT; ++mt)
#pragma unroll
      for (int nq = 0; nq < NQ; ++nq)
#pragma unroll
        for (int j = 0; j < 4; ++j) {
          const size_t idx = (size_t)(mt_ * 256 + wm * 128 + mt * 16 + quad * 4 + j) * DM + nt * 256 + wn * 64 + nq * 16 + r16;
          hout[idx] = hin[idx] + acc[mt][nq][j];
        }
  }
}

DI_ void ssm_pre_phase(const Params& p, float* sm, bf16_t* WgT, bf16_t* YgT, float* lamL) {
  int tid_ = threadIdx.x; asm volatile("" : "+v"(tid_)); const int tid = tid_;
  const float *a_re = p.in[11], *a_im = p.in[12], *log_step = p.in[13], *b_re = p.in[14], *b_im = p.in[15];
  const float *c_re = p.in[16], *c_im = p.in[17], *d_skip = p.in[18];
  float* lp_re = sm;
  float* lp_im = sm + 17 * 64;
  float* bb_re = sm + 34 * 64;
  float* bb_im = bb_re + 1024;
  float* cc_re = bb_im + 1024;
  float* cc_im = cc_re + 1024;
  float* cf = cc_im + 1024;
  float* Kt = cf + 128;
  for (int item = blockIdx.x; item < 256; item += gridDim.x) {
    const int g = item >> 1, half = item & 1;
    __syncthreads();
    if (tid < 64) {
      const float st = expf(log_step[g]);
      const float ar = a_re[g * 64 + tid], ai = a_im[g * 64 + tid];
      const float zr = ar * st, zi = ai * st;
      for (int tau = 0; tau <= 16; ++tau) {
        float e = expf(zr * (float)tau), sn, cs;
        sincos_red(zi * (float)tau, &sn, &cs);
        lp_re[tau * 64 + tid] = e * cs; lp_im[tau * 64 + tid] = e * sn;
      }
      float sn, cs; sincos_red(zi, &sn, &cs);
      float sh, ch; sincos_red(0.5f * zi, &sh, &ch);
      const float em1 = expm1f(zr);
      const float nr = em1 * cs - 2.f * sh * sh, ni = (em1 + 1.f) * sn;
      const float den = 1.f / (ar * ar + ai * ai);
      cf[tid] = (nr * ar + ni * ai) * den; cf[64 + tid] = (ni * ar - nr * ai) * den;
    }
    __syncthreads();
    for (int e = tid; e < 1024; e += NT) {
      const int pp = e >> 4;
      const float br = b_re[(size_t)g * 1024 + e], bi = b_im[(size_t)g * 1024 + e];
      const float cr = cf[pp], ci = cf[64 + pp];
      bb_re[e] = cr * br - ci * bi; bb_im[e] = cr * bi + ci * br;
      cc_re[e] = c_re[(size_t)g * 1024 + e]; cc_im[e] = c_im[(size_t)g * 1024 + e];
    }
    __syncthreads();
    for (int e = tid; e < 4096; e += NT) {
      const int tau = e >> 8, ho = (e >> 4) & 15, hi = e & 15;
      float acc = 0.f;
      for (int pp = 0; pp < 64; ++pp) {
        const float cr = cc_re[ho * 64 + pp], ci = cc_im[ho * 64 + pp];
        const float lr = lp_re[tau * 64 + pp], li = lp_im[tau * 64 + pp];
        const float dr = cr * lr - ci * li, di = cr * li + ci * lr;
        acc += dr * bb_re[pp * 16 + hi] - di * bb_im[pp * 16 + hi];
      }
      if (tau == 0 && ho == hi) acc += d_skip[g * 16 + ho];
      Kt[e] = acc;
    }
    __syncthreads();
    for (int e = half * 32768 + tid; e < (half + 1) * 32768; e += NT) {
      const int n = e >> 8, k = e & 255, t = n >> 4, ho = n & 15, sx = k >> 4, hi = k & 15;
      const float v = (sx <= t) ? Kt[((t - sx) * 16 + ho) * 16 + hi] : 0.f;
      YgT[((size_t)g * 256 + n) * 384 + k] = f2bf(v);
    }
    for (int e = half * 8192 + tid; e < (half + 1) * 8192; e += NT) {
      const int n = e >> 6, pp = e & 63, t = n >> 4, ho = n & 15;
      const float cr = cc_re[ho * 64 + pp], ci = cc_im[ho * 64 + pp];
      const float lr = lp_re[(t + 1) * 64 + pp], li = lp_im[(t + 1) * 64 + pp];
      YgT[((size_t)g * 256 + n) * 384 + 256 + pp] = f2bf(cr * lr - ci * li);
      YgT[((size_t)g * 256 + n) * 384 + 320 + pp] = f2bf(-(cr * li + ci * lr));
    }
    for (int e = half * 8192 + tid; e < (half + 1) * 8192; e += NT) {
      const int pp = e >> 8, k = e & 255, j = k >> 4, hh = k & 15;
      const float lr = lp_re[(15 - j) * 64 + pp], li = lp_im[(15 - j) * 64 + pp];
      const float br = bb_re[pp * 16 + hh], bi = bb_im[pp * 16 + hh];
      WgT[((size_t)g * 128 + pp) * 256 + k] = f2bf(lr * br - li * bi);
      WgT[((size_t)g * 128 + 64 + pp) * 256 + k] = f2bf(lr * bi + li * br);
    }
    if (tid < 64) { lamL[g * 128 + tid] = lp_re[16 * 64 + tid]; lamL[g * 128 + 64 + tid] = lp_im[16 * 64 + tid]; }
  }
}

DI_ void s5_inu_phase(const bf16_t* HB, const bf16_t* WinT, bf16_t* Uc, bf16_t* smem) {
  TILE_IDS(); CFG_A16();
  for (int t = blockIdx.x; t < 64 * 8; t += gridDim.x) {
    const int mt_ = (t & 7) + 8 * (t >> 6), nt = (t >> 3) & 7;
    GemmArgs g{HB + (size_t)mt_ * 256 * DM, DM, nullptr, 0, 1 << 30, WinT + (size_t)nt * 256 * DM, DM, 16};
    f32x4 acc[MT][NQ];
    gemm_mainloop16<WM, WN, MT, NQ>(g, smem, acc);
    {
      bf16_t* st = smem + w * (128 * LDS_STRIDE);
#pragma unroll
      for (int mt = 0; mt < MT; ++mt)
#pragma unroll
        for (int nq = 0; nq < NQ; ++nq)
#pragma unroll
          for (int j = 0; j < 4; ++j) {
            const int rl = mt * 16 + quad * 4 + j, cl = nq * 16 + r16;
            st[((cl >> 4) * 8 + (rl >> 4)) * 256 + (rl & 15) * 16 + (cl & 15)] = f2bf(acc[mt][nq][j]);
          }
      stage_sync();
      const int g0 = (nt * 256 + wn * 64) >> 4, n0 = (mt_ * 256 + wm * 128) >> 4;
#pragma unroll 4
      for (int it = 0; it < 16; ++it) {
        const int blk = it * 2 + (lane >> 5), gl = blk >> 3, nl = blk & 7;
        const uint4 v = *(const uint4*)(st + blk * 256 + (lane & 31) * 8);
        *(uint4*)(Uc + ((size_t)(g0 + gl) * 1024 + n0 + nl) * 256 + (lane & 31) * 8) = v;
      }
      stage_sync();
    }
  }
}
DI_ void s5_inz_phase(const bf16_t* HB, const bf16_t* WinTz, bf16_t* Z, bf16_t* smem) {
  TILE_IDS(); CFG_A16();
  for (int t = blockIdx.x; t < 64 * 8; t += gridDim.x) {
    const int mt_ = (t & 7) + 8 * (t >> 6), nt = (t >> 3) & 7;
    GemmArgs g{HB + (size_t)mt_ * 256 * DM, DM, nullptr, 0, 1 << 30, WinTz + (size_t)nt * 256 * DM, DM, 16};
    f32x4 acc[MT][NQ];
    gemm_mainloop16<WM, WN, MT, NQ>(g, smem, acc);
    bf16_t* st = wave_stage<128>(smem, w);
#pragma unroll
    for (int mt = 0; mt < MT; ++mt)
#pragma unroll
      for (int nq = 0; nq < NQ; ++nq)
#pragma unroll
        for (int j = 0; j < 4; ++j)
          st[(mt * 16 + quad * 4 + j) * LDS_STRIDE + nq * 16 + r16] = f2bf(siluf_(acc[mt][nq][j]));
    stage_flush<128, 64>(st, Z + (size_t)(mt_ * 256 + wm * 128) * DIN + nt * 256 + wn * 64, DIN, lane);
  }
}
DI_ void s5_ygemm_tile(int gi, int mt_, const bf16_t* Uc, const bf16_t* Sx, const bf16_t* YgT, bf16_t* Y, bf16_t* smem);
DI_ void s5_sgemm_phase(const bf16_t* Uc, const bf16_t* WgT, const float* lamL, bf16_t* Sx, const bf16_t* YgT, bf16_t* Y, bf16_t* smem) {
  TILE_IDS(); CFG_B16();
  float* Sl = (float*)smem;
  float* xch = Sl + 256 * 129;
  for (int t = blockIdx.x; t < 128 * 4; t += gridDim.x) {
    const int xq = t & 7, kq = t >> 3;
    const int gi = xq * 16 + (kq >> 2), mt_ = kq & 3;
    GemmArgs g{Uc + ((size_t)gi * 1024 + mt_ * 256) * 256, 256, nullptr, 0, 1 << 30, WgT + (size_t)gi * 128 * 256, 256, 4};
    f32x4 acc[MT][NQ];
    gemm_mainloop16<WM, WN, MT, NQ>(g, smem, acc);
#pragma unroll
    for (int mt = 0; mt < MT; ++mt)
#pragma unroll
      for (int nq = 0; nq < NQ; ++nq)
#pragma unroll
        for (int j = 0; j < 4; ++j)
          Sl[(wm * 64 + mt * 16 + quad * 4 + j) * 129 + wn * 64 + nq * 16 + r16] = acc[mt][nq][j];
    __syncthreads();
    {
      const int pp = tid & 63, seg = tid >> 6;
      const float lr = lamL[gi * 128 + pp], li = lamL[gi * 128 + 64 + pp];
      const float* sp = Sl + (seg * 32) * 129 + pp;
      float xr = 0.f, xi = 0.f;
#pragma unroll 8
      for (int c = 0; c < 32; ++c) { const float sr = sp[c * 129], si = sp[c * 129 + 64]; const float tt = lr * xr - li * xi + sr; xi = lr * xi + li * xr + si; xr = tt; }
      xch[seg * 128 + pp] = xr; xch[seg * 128 + 64 + pp] = xi;
      __syncthreads();
      float ar = lr, ai = li;
#pragma unroll
      for (int q = 0; q < 5; ++q) { const float tt = ar * ar - ai * ai; ai = 2.f * ar * ai; ar = tt; }
      xr = 0.f; xi = 0.f;
      for (int s2 = 0; s2 < seg; ++s2) { const float tt = ar * xr - ai * xi + xch[s2 * 128 + pp]; xi = ar * xi + ai * xr + xch[s2 * 128 + 64 + pp]; xr = tt; }
      bf16_t* base = Sx + ((size_t)(mt_ * 256 + seg * 32) * 128 + gi) * 128 + pp;
#pragma unroll 8
      for (int c = 0; c < 32; ++c) {
        base[(size_t)c * 16384] = f2bf(xr); base[(size_t)c * 16384 + 64] = f2bf(xi);
        const float sr = sp[c * 129], si = sp[c * 129 + 64];
        const float tt = lr * xr - li * xi + sr; xi = lr * xi + li * xr + si; xr = tt;
      }
    }
    asm volatile("s_waitcnt vmcnt(0)" ::: "memory");
    s5_ygemm_tile(gi, mt_, Uc, Sx, YgT, Y, smem);
  }
}
DI_ void s5_scan_phase(bf16_t* Sx, const float* lamL, float* sm) {
  int tid_ = threadIdx.x; asm volatile("" : "+v"(tid_)); const int tid = tid_;
  const int pp = tid & 63, seg = tid >> 6;
  for (int item = blockIdx.x; item < 512; item += gridDim.x) {
    const int b = item >> 7, g = item & 127;
    const float lr = lamL[g * 128 + pp], li = lamL[g * 128 + 64 + pp];
    bf16_t* base = Sx + ((size_t)(b * 256 + seg * 32) * 128 + g) * 128 + pp;
    float xr = 0.f, xi = 0.f;
    for (int c0 = 0; c0 < 32; c0 += 8) {
      float sr[8], si[8];
#pragma unroll
      for (int c = 0; c < 8; ++c) { sr[c] = bf2f(base[(size_t)(c0 + c) * 16384]); si[c] = bf2f(base[(size_t)(c0 + c) * 16384 + 64]); }
#pragma unroll
      for (int c = 0; c < 8; ++c) { const float t = lr * xr - li * xi + sr[c]; xi = lr * xi + li * xr + si[c]; xr = t; }
    }
    __syncthreads();
    sm[seg * 128 + pp] = xr; sm[seg * 128 + 64 + pp] = xi;
    __syncthreads();
    float ar = lr, ai = li;
#pragma unroll
    for (int q = 0; q < 5; ++q) { const float t = ar * ar - ai * ai; ai = 2.f * ar * ai; ar = t; }
    xr = 0.f; xi = 0.f;
    for (int s2 = 0; s2 < seg; ++s2) { const float t = ar * xr - ai * xi + sm[s2 * 128 + pp]; xi = ar * xi + ai * xr + sm[s2 * 128 + 64 + pp]; xr = t; }
    for (int c0 = 0; c0 < 32; c0 += 8) {
      float sr[8], si[8];
#pragma unroll
      for (int c = 0; c < 8; ++c) { sr[c] = bf2f(base[(size_t)(c0 + c) * 16384]); si[c] = bf2f(base[(size_t)(c0 + c) * 16384 + 64]); }
#pragma unroll
      for (int c = 0; c < 8; ++c) {
        base[(size_t)(c0 + c) * 16384] = f2bf(xr); base[(size_t)(c0 + c) * 16384 + 64] = f2bf(xi);
        const float t = lr * xr - li * xi + sr[c]; xi = lr * xi + li * xr + si[c]; xr = t;
      }
    }
  }
}
DI_ void s5_ygemm_tile(int gi, int mt_, const bf16_t* Uc, const bf16_t* Sx, const bf16_t* YgT, bf16_t* Y, bf16_t* smem) {
  TILE_IDS(); CFG_A16();
  GemmArgs g{Uc + ((size_t)gi * 1024 + mt_ * 256) * 256, 256, Sx + ((size_t)mt_ * 256 * 128 + gi) * 128, 16384, 4,
             YgT + (size_t)gi * 256 * 384, 384, 6};
  f32x4 acc[MT][NQ];
  gemm_mainloop16<WM, WN, MT, NQ>(g, smem, acc);
#pragma unroll
  for (int mt = 0; mt < MT; ++mt)
#pragma unroll
    for (int nq = 0; nq < NQ; ++nq)
#pragma unroll
      for (int j = 0; j < 4; ++j) {
        const int row = mt_ * 256 + wm * 128 + mt * 16 + quad * 4 + j;
        Y[((size_t)row * 16 + wn * 4 + nq) * DIN + gi * 16 + r16] = f2bf(geluf_(acc[mt][nq][j]));
      }
}
DI_ void s5_glu_phase(const bf16_t* HB, const bf16_t* WinTz, const bf16_t* Y, const bf16_t* WgluT, const float* b_glu, bf16_t* Z, bf16_t* smem) {
  TILE_IDS(); CFG_A16();
  for (int t = blockIdx.x; t < 64 * 8; t += gridDim.x) {
    const int mt_ = (t & 7) + 8 * (t >> 6), nt = (t >> 3) & 7;
    f32x4 acc[MT][NQ];
    {
      GemmArgs gz{HB + (size_t)mt_ * 256 * DM, DM, nullptr, 0, 1 << 30, WinTz + (size_t)nt * 256 * DM, DM, 16};
      gemm_mainloop16<WM, WN, MT, NQ>(gz, smem, acc);
      bf16_t* stz = wave_stage<128>(smem, w);
#pragma unroll
      for (int mt = 0; mt < MT; ++mt)
#pragma unroll
        for (int nq = 0; nq < NQ; ++nq)
#pragma unroll
          for (int j = 0; j < 4; ++j)
            stz[(mt * 16 + quad * 4 + j) * LDS_STRIDE + nq * 16 + r16] = f2bf(siluf_(acc[mt][nq][j]));
      stage_flush<128, 64>(stz, Z + (size_t)(mt_ * 256 + wm * 128) * DIN + nt * 256 + wn * 64, DIN, lane);
    }
    GemmArgs g{Y + (size_t)mt_ * 256 * DIN, DIN, nullptr, 0, 1 << 30, WgluT + (size_t)nt * 256 * DIN, DIN, 32};
    gemm_mainloop16<WM, WN, MT, NQ>(g, smem, acc);
    {
      bf16_t* stY = smem + w * (128 * LDS_STRIDE);
      bf16_t* stZ = stY + 64 * LDS_STRIDE;
      const float* bgp = b_glu + nt * 256 + wn * 64 + r16;
      const float bg0 = bgp[0], bg1 = bgp[16], bg2 = bgp[32], bg3 = bgp[48];
#pragma unroll
      for (int h2 = 0; h2 < 2; ++h2) {
        const size_t off = (size_t)(mt_ * 256 + wm * 128 + h2 * 64) * DIN + nt * 256 + wn * 64;
        stage_load<64, 64>(stY, Y + off, DIN, lane);
        stage_load<64, 64>(stZ, Z + off, DIN, lane);
#pragma unroll
        for (int m2 = 0; m2 < 4; ++m2)
#pragma unroll
          for (int nq = 0; nq < NQ; ++nq)
#pragma unroll
            for (int j = 0; j < 4; ++j) {
              const int idx = (m2 * 16 + quad * 4 + j) * LDS_STRIDE + nq * 16 + r16;
              const float yv = bf2f(stY[idx]);
              stZ[idx] = f2bf(yv * sigmoidf_(acc[h2 * 4 + m2][nq][j] + (nq == 0 ? bg0 : nq == 1 ? bg1 : nq == 2 ? bg2 : bg3)) * bf2f(stZ[idx]));
            }
        stage_flush<64, 64>(stZ, Z + off, DIN, lane);
      }
    }
  }
}

DI_ void mla_wq_phase(const float* w_uq, const float* w_ukv, const float* gq, const float* gkv, bf16_t* WqT, float* sm) {
  int tid_ = threadIdx.x; asm volatile("" : "+v"(tid_)); const int tid = tid_;
  float* As = sm;
  float* Bs = sm + 32 * 129;
  float* Os = Bs + 128 * 129;
  for (int item = blockIdx.x; item < 16 * 12; item += gridDim.x) {
    const int h = item / 12, c0 = (item % 12) * 32;
    __syncthreads();
#pragma unroll
    for (int q = 0; q < 2; ++q) {
      const int e = tid + q * NT, ci = e >> 5, d4 = e & 31;
      const float4 v = *(const float4*)(w_uq + (size_t)(c0 + ci) * 3072 + h * 192 + d4 * 4);
      float* p_ = As + ci * 129 + d4 * 4; p_[0] = v.x; p_[1] = v.y; p_[2] = v.z; p_[3] = v.w;
    }
#pragma unroll
    for (int q = 0; q < 8; ++q) {
      const int e = tid + q * NT, rr = e >> 5, d4 = e & 31;
      const float4 v = *(const float4*)(w_ukv + (size_t)rr * 4096 + h * 256 + d4 * 4);
      float* p_ = Bs + rr * 129 + d4 * 4; p_[0] = v.x; p_[1] = v.y; p_[2] = v.z; p_[3] = v.w;
    }
    __syncthreads();
    {
      const int rr = tid & 127, cg = tid >> 7;
      float acc[8];
#pragma unroll
      for (int j = 0; j < 8; ++j) acc[j] = 0.f;
      for (int d = 0; d < 128; ++d) {
        const float bv = Bs[rr * 129 + d];
#pragma unroll
        for (int j = 0; j < 8; ++j) acc[j] += As[(cg + 4 * j) * 129 + d] * bv;
      }
      const float gk = gkv[rr];
#pragma unroll
      for (int j = 0; j < 8; ++j) Os[rr * 33 + cg + 4 * j] = acc[j] * gk * gq[c0 + cg + 4 * j];
    }
    __syncthreads();
#pragma unroll
    for (int q = 0; q < 8; ++q) {
      const int e = tid + q * NT, rr = e >> 5, ci = e & 31;
      WqT[(size_t)(h * 192 + rr) * 384 + c0 + ci] = f2bf(Os[rr * 33 + ci]);
    }
  }
  for (int idx = blockIdx.x * NT + tid; idx < 16 * 64 * 384; idx += gridDim.x * NT) {
    const int c = idx % 384, nn = idx / 384, h = nn >> 6, j = nn & 63, n = h * 192 + 128 + j;
    WqT[(size_t)n * 384 + c] = f2bf(w_uq[(size_t)c * 3072 + n] * gq[c]);
  }
}
DI_ void rope_table_phase(const int* pos, float* cosT, float* sinT) {
  for (int idx = blockIdx.x * NT + threadIdx.x; idx < T_TOK * 32; idx += gridDim.x * NT) {
    const float ang = (float)pos[idx >> 5] * INVF[idx & 31];
    float sn, cs; sincos_red(ang, &sn, &cs);
    cosT[idx] = cs; sinT[idx] = sn;
  }
}
DI_ void mla_in_phase(const bf16_t* HB, const bf16_t* WinT, bf16_t* cq, float* qssq, float* ckv, bf16_t* Kc, bf16_t* Z,
                      const float* cosT, const float* sinT, bf16_t* smem) {
  TILE_IDS(); CFG_A16();
  for (int t = blockIdx.x; t < 64 * 11; t += gridDim.x) {
    const int mt_ = (t & 7) + 8 * (t / 88), nt = (t >> 3) % 11;
    GemmArgs g{HB + (size_t)mt_ * 256 * DM, DM, nullptr, 0, 1 << 30, WinT + (size_t)nt * 256 * DM, DM, 16};
    f32x4 acc[MT][NQ];
    gemm_mainloop16<WM, WN, MT, NQ>(g, smem, acc);
    const int rbase = mt_ * 256 + wm * 128;
    const int cb = nt * 4 + wn;
    bf16_t* st = wave_stage<128>(smem, w);
    if (cb < 6) {
#pragma unroll
      for (int mt = 0; mt < MT; ++mt)
#pragma unroll
        for (int nq = 0; nq < NQ; ++nq)
#pragma unroll
          for (int j = 0; j < 4; ++j)
            st[(mt * 16 + quad * 4 + j) * LDS_STRIDE + nq * 16 + r16] = f2bf(acc[mt][nq][j]);
      stage_rowstats<128>(st, lane, [&](int row, float s1, float s2) { (void)s1; qssq[(size_t)(rbase + row) * 8 + cb] = s2; });
      stage_flush<128, 64>(st, cq + (size_t)rbase * 384 + cb * 64, 384, lane);
    } else if (cb < 8) {
#pragma unroll
      for (int mt = 0; mt < MT; ++mt)
#pragma unroll
        for (int nq = 0; nq < NQ; ++nq)
#pragma unroll
          for (int j = 0; j < 4; ++j)
            ckv[(size_t)(rbase + mt * 16 + quad * 4 + j) * 128 + (cb - 6) * 64 + nq * 16 + r16] = acc[mt][nq][j];
    } else if (cb == 8) {
#pragma unroll
      for (int mt = 0; mt < MT; ++mt) {
#pragma unroll
        for (int nq = 0; nq < 2; ++nq)
#pragma unroll
          for (int j = 0; j < 4; ++j) {
            const int row = rbase + mt * 16 + quad * 4 + j, jj = nq * 16 + r16;
            const float cs = cosT[(size_t)row * 32 + jj], sn = sinT[(size_t)row * 32 + jj];
            const float x1 = acc[mt][nq][j], x2 = acc[mt][nq + 2][j];
            Kc[(size_t)row * 192 + 128 + jj] = f2bf(x1 * cs - x2 * sn);
            Kc[(size_t)row * 192 + 160 + jj] = f2bf(x2 * cs + x1 * sn);
          }
        asm volatile("" ::: "memory");
      }
    } else if (cb >= 10 && cb < 42) {
#pragma unroll
      for (int mt = 0; mt < MT; ++mt)
#pragma unroll
        for (int nq = 0; nq < NQ; ++nq)
#pragma unroll
          for (int j = 0; j < 4; ++j)
            st[(mt * 16 + quad * 4 + j) * LDS_STRIDE + nq * 16 + r16] = f2bf(siluf_(acc[mt][nq][j]));
      stage_flush<128, 64>(st, Z + (size_t)rbase * DIN + (cb - 10) * 64, DIN, lane);
    }
  }
}
DI_ void mla_q_phase(const bf16_t* cq, const float* qssq, const bf16_t* WqT, bf16_t* Qp, const float* cosT, const float* sinT,
                     const float* ckv, bf16_t* Kc, bf16_t* KcT, bf16_t* smem) {
  TILE_IDS(); CFG_A16();
  const float QSC = 0.07216878364870322f * 1.4426950408889634f;
  float* fsc = (float*)((unsigned char*)smem + SMEM_MAIN);
  for (int t = blockIdx.x; t < 64 * 12; t += gridDim.x) {
    const int mt_ = (t & 7) + 8 * (t / 96), nt = (t >> 3) % 12;
    GemmArgs g{cq + (size_t)mt_ * 256 * 384, 384, nullptr, 0, 1 << 30, WqT + (size_t)nt * 256 * 384, 384, 6};
    f32x4 acc[MT][NQ];
    __syncthreads();
    if (tid < 256) {
      const float* ps = qssq + (size_t)(mt_ * 256 + tid) * 8;
      const float ss = ps[0] + ps[1] + ps[2] + ps[3] + ps[4] + ps[5];
      fsc[tid] = rsqrtf(ss * (1.f / 384.f) + 1e-6f) * QSC;
    }
    gemm_mainloop16s<WM, WN, MT, NQ>(g, smem, acc);
    const int cb = nt * 4 + wn;
    const bool is_rope = (cb % 3) == 2;
    const int colb = cb * 64;
    bf16_t* st = wave_stage<128>(smem, w);
#pragma unroll
    for (int mt = 0; mt < MT; ++mt) {
#pragma unroll
      for (int nq = 0; nq < 2; ++nq)
#pragma unroll
        for (int j = 0; j < 4; ++j) {
          const int rl = mt * 16 + quad * 4 + j, jj = nq * 16 + r16;
          const float f = fsc[wm * 128 + rl];
          float x1 = acc[mt][nq][j] * f, x2 = acc[mt][nq + 2][j] * f;
          if (is_rope) {
            const int row = mt_ * 256 + wm * 128 + rl;
            const float cs = cosT[(size_t)row * 32 + jj], sn = sinT[(size_t)row * 32 + jj];
            const float y1 = x1 * cs - x2 * sn, y2 = x2 * cs + x1 * sn;
            x1 = y1; x2 = y2;
          }
          st[rl * LDS_STRIDE + jj] = f2bf(x1);
          st[rl * LDS_STRIDE + 32 + jj] = f2bf(x2);
        }
      asm volatile("" ::: "memory");
      __builtin_amdgcn_sched_barrier(0);
    }
    stage_flush<128, 64>(st, Qp + (size_t)(mt_ * 256 + wm * 128) * 3072 + colb, 3072, lane);
  }
  float* tl = (float*)smem;
  float* rs = tl + 64 * 129;
  for (int item = blockIdx.x; item < T_TOK / 64; item += gridDim.x) {
    const int t0 = item * 64;
    __syncthreads();
    for (int e = tid; e < 64 * 128; e += NT) tl[(e >> 7) * 129 + (e & 127)] = ckv[(size_t)t0 * 128 + e];
    __syncthreads();
    {
      const int tok = tid >> 3, part = tid & 7;
      float ss = 0.f;
      for (int j = 0; j < 16; ++j) { const float v = tl[tok * 129 + part * 16 + j]; ss += v * v; }
      ss += __shfl_xor(ss, 1); ss += __shfl_xor(ss, 2); ss += __shfl_xor(ss, 4);
      if (part == 0) rs[tok] = rsqrtf(ss * (1.f / 128.f) + 1e-6f);
    }
    __syncthreads();
    for (int e = tid; e < 64 * 128; e += NT) {
      const int tok = e >> 7, rr = e & 127;
      Kc[(size_t)(t0 + tok) * 192 + rr] = f2bf(tl[tok * 129 + rr] * rs[tok]);
    }
    const int b = t0 >> 12, l0 = t0 & 4095;
    for (int e = tid; e < 64 * 128; e += NT) {
      const int rr = e >> 6, tok = e & 63;
      KcT[((size_t)b * 128 + rr) * SEQ + l0 + tok] = f2bf(tl[tok * 129 + rr] * rs[tok]);
    }
  }
}

constexpr int KT = 64;
constexpr int NSUB = KT / 32;
constexpr int KS_STRIDE = 200;
constexpr int VS_STRIDE = KT + 4;
DI_ void mla_attn_phase(const bf16_t* Qp, const bf16_t* Kc, const bf16_t* KcT, const bf16_t* WuvT, bf16_t* Z, bf16_t* smem) {
  TILE_IDS();
  bf16_t* Ks = smem;
  bf16_t* Vs = smem + KT * KS_STRIDE;
  bf16_t* Ws = smem + 36864;
  const int G = gridDim.x;
  for (int round = 0;; ++round) {
    const int slot = (round & 1) ? (G - 1 - (int)blockIdx.x) : (int)blockIdx.x;
    const int item = round * G + slot;
    if (item >= 1024) break;
    const int qb = 15 - (item >> 6), bh = item & 63, b = bh >> 4, h = bh & 15;
    const int q0 = qb * 256, qw0 = q0 + w * 32, qrow = qw0 + r;
    const size_t tok = (size_t)b * SEQ + qrow;
    bf16x8 qf[12];
    {
      const bf16_t* qptr = Qp + tok * 3072 + h * 192 + hf * 8;
#pragma unroll
      for (int ks = 0; ks < 12; ++ks) qf[ks] = *(const bf16x8*)(qptr + ks * 16);
    }
    {
      const bf16_t* wsrc = WuvT + (size_t)h * 128 * 128;
#pragma unroll
      for (int i = 0; i < 4; ++i) {
        const int row = i * 32 + (tid >> 4), slot = tid & 15;
        __builtin_amdgcn_global_load_lds((const unsigned*)(wsrc + row * 128 + ((slot ^ (row & 15)) * 8)), (unsigned*)(Ws + (i * NT + tid) * 8), 16, 0, 0);
      }
    }
    f32x16 O[4];
#pragma unroll
    for (int dt = 0; dt < 4; ++dt)
#pragma unroll
      for (int i = 0; i < 16; ++i) O[dt][i] = 0.f;
    float m = -1e30f, ls = 0.f;
    const int ntile = (q0 + 256) / KT;
    const bf16_t* Kg = Kc + (size_t)b * SEQ * 192;
    const bf16_t* Vg = KcT + (size_t)b * 128 * SEQ;
    const int kc0 = tid, kc1 = tid + 512, kc2 = tid + 1024;
    const int kr0 = kc0 / 24, kr1 = kc1 / 24, kr2 = kc2 / 24;
    const int ko0 = kr0 * 192 + (kc0 - kr0 * 24) * 8, ko1 = kr1 * 192 + (kc1 - kr1 * 24) * 8, ko2 = kr2 * 192 + (kc2 - kr2 * 24) * 8;
    const int kl0 = kr0 * KS_STRIDE + (kc0 - kr0 * 24) * 8, kl1 = kr1 * KS_STRIDE + (kc1 - kr1 * 24) * 8, kl2 = kr2 * KS_STRIDE + (kc2 - kr2 * 24) * 8;
    const int vr0 = tid >> 3, vr1 = (tid + 512) >> 3, vcc = (tid & 7) * 8;
    uint4 rk0 = *(const uint4*)(Kg + ko0), rk1 = *(const uint4*)(Kg + ko1), rk2 = *(const uint4*)(Kg + ko2);
    uint4 rv0 = *(const uint4*)(Vg + (size_t)vr0 * SEQ + vcc), rv1 = *(const uint4*)(Vg + (size_t)vr1 * SEQ + vcc);
    for (int kt = 0; kt < ntile; ++kt) {
      __syncthreads();
      *(uint4*)(Ks + kl0) = rk0; *(uint4*)(Ks + kl1) = rk1; *(uint4*)(Ks + kl2) = rk2;
      { uint2 lo, hi; lo.x = rv0.x; lo.y = rv0.y; hi.x = rv0.z; hi.y = rv0.w;
        *(uint2*)(Vs + vr0 * VS_STRIDE + vcc) = lo; *(uint2*)(Vs + vr0 * VS_STRIDE + vcc + 4) = hi; }
      { uint2 lo, hi; lo.x = rv1.x; lo.y = rv1.y; hi.x = rv1.z; hi.y = rv1.w;
        *(uint2*)(Vs + vr1 * VS_STRIDE + vcc) = lo; *(uint2*)(Vs + vr1 * VS_STRIDE + vcc + 4) = hi; }
      __syncthreads();
      if (kt + 1 < ntile) {
        const int k1 = (kt + 1) * KT;
        const bf16_t* Kn = Kg + (size_t)k1 * 192;
        rk0 = *(const uint4*)(Kn + ko0); rk1 = *(const uint4*)(Kn + ko1); rk2 = *(const uint4*)(Kn + ko2);
        rv0 = *(const uint4*)(Vg + (size_t)vr0 * SEQ + k1 + vcc); rv1 = *(const uint4*)(Vg + (size_t)vr1 * SEQ + k1 + vcc);
      }
      const int k0 = kt * KT;
      if (k0 <= qw0 + 31) {
        f32x16 st[NSUB];
#pragma unroll
        for (int sub = 0; sub < NSUB; ++sub) {
#pragma unroll
          for (int i = 0; i < 16; ++i) st[sub][i] = 0.f;
#pragma unroll
          for (int ks = 0; ks < 12; ++ks) {
            bf16x8 a = *(const bf16x8*)(Ks + (sub * 32 + r) * KS_STRIDE + ks * 16 + hf * 8);
            st[sub] = MFMA32(a, qf[ks], st[sub]);
            if ((ks & 3) == 3) __builtin_amdgcn_sched_barrier(0);
          }
        }
        if (k0 + KT - 1 > qw0) {
#pragma unroll
          for (int sub = 0; sub < NSUB; ++sub)
#pragma unroll
            for (int i = 0; i < 16; ++i)
              if (k0 + sub * 32 + crow(i, hf) > qrow) st[sub][i] = -1e30f;
        }
        float mx = -1e30f;
#pragma unroll
        for (int sub = 0; sub < NSUB; ++sub)
#pragma unroll
          for (int i = 0; i < 16; ++i) mx = fmaxf(mx, st[sub][i]);
        mx = fmaxf(mx, __shfl_xor(mx, 32));
        if (!__all(mx - m <= 8.f)) {
          const float mn = fmaxf(m, mx);
          const float alpha = __builtin_amdgcn_exp2f(m - mn);
          m = mn;
          ls *= alpha;
#pragma unroll
          for (int dt = 0; dt < 4; ++dt)
#pragma unroll
            for (int i = 0; i < 16; ++i) O[dt][i] *= alpha;
        }
        float psum = 0.f;
#pragma unroll
        for (int sub = 0; sub < NSUB; ++sub)
#pragma unroll
          for (int i = 0; i < 16; ++i) { const float pv = __builtin_amdgcn_exp2f(st[sub][i] - m); st[sub][i] = pv; psum += pv; }
        ls += psum;
#pragma unroll
        for (int sub = 0; sub < NSUB; ++sub)
#pragma unroll
          for (int s2 = 0; s2 < 2; ++s2) {
            u32x4 pfu;
#pragma unroll
            for (int j = 0; j < 4; ++j) pfu[j] = pack2(st[sub][8 * s2 + 2 * j], st[sub][8 * s2 + 2 * j + 1]);
            const bf16x8 pf = __builtin_bit_cast(bf16x8, pfu);
#pragma unroll
            for (int dt = 0; dt < 4; ++dt) {
              const bf16_t* vp = Vs + (dt * 32 + r) * VS_STRIDE + sub * 32 + s2 * 16 + hf * 4;
              const uint2 vlo = *(const uint2*)vp;
              const uint2 vhi = *(const uint2*)(vp + 8);
              u32x4 vau; vau[0] = vlo.x; vau[1] = vlo.y; vau[2] = vhi.x; vau[3] = vhi.y;
              O[dt] = MFMA32(__builtin_bit_cast(bf16x8, vau), pf, O[dt]);
            }
          }
      }
    }
    const float lt = ls + __shfl_xor(ls, 32);
    const float inv = 1.f / lt;
    f32x16 U[4];
#pragma unroll
    for (int dq = 0; dq < 4; ++dq)
#pragma unroll
      for (int i = 0; i < 16; ++i) U[dq][i] = 0.f;
#pragma unroll
    for (int dt = 0; dt < 4; ++dt)
#pragma unroll
      for (int s2 = 0; s2 < 2; ++s2) {
        u32x4 ofu;
#pragma unroll
        for (int j = 0; j < 4; ++j) ofu[j] = pack2(O[dt][8 * s2 + 2 * j] * inv, O[dt][8 * s2 + 2 * j + 1] * inv);
        const bf16x8 of = __builtin_bit_cast(bf16x8, ofu);
        const int dv0 = dt * 32 + s2 * 16 + hf * 4;
        const int c0 = dv0 >> 3, hb = (dv0 & 7);
#pragma unroll
        for (int dq = 0; dq < 4; ++dq) {
          const int R = dq * 32 + r;
          const uint2 wlo = *(const uint2*)(Ws + R * 128 + ((c0 ^ (R & 15)) * 8) + hb);
          const uint2 whi = *(const uint2*)(Ws + R * 128 + (((c0 + 1) ^ (R & 15)) * 8) + hb);
          u32x4 wau; wau[0] = wlo.x; wau[1] = wlo.y; wau[2] = whi.x; wau[3] = whi.y;
          U[dq] = MFMA32(__builtin_bit_cast(bf16x8, wau), of, U[dq]);
        }
      }
    __syncthreads();
    {
      bf16_t* so = smem + w * (32 * 136);
#pragma unroll
      for (int dq = 0; dq < 4; ++dq)
#pragma unroll
        for (int i4 = 0; i4 < 4; ++i4) {
          uint2 o;
          o.x = pack2(U[dq][i4 * 4 + 0], U[dq][i4 * 4 + 1]);
          o.y = pack2(U[dq][i4 * 4 + 2], U[dq][i4 * 4 + 3]);
          *(uint2*)(so + r * 136 + dq * 32 + i4 * 8 + hf * 4) = o;
        }
      stage_sync();
      bf16_t* zb = Z + ((size_t)b * SEQ + qw0) * DIN + h * 128;
#pragma unroll 4
      for (int it = 0; it < 8; ++it) {
        const int row = it * 4 + (lane >> 4), ch = lane & 15;
        const uint4 uv = *(const uint4*)(so + row * 136 + ch * 8);
        bf16_t* pz = zb + (size_t)row * DIN + ch * 8;
        const uint4 zv = *(const uint4*)pz;
        const unsigned uu[4] = {uv.x, uv.y, uv.z, uv.w}, zz[4] = {zv.x, zv.y, zv.z, zv.w};
        unsigned oo[4];
#pragma unroll
        for (int j = 0; j < 4; ++j)
          oo[j] = pack2(__uint_as_float(uu[j] << 16) * __uint_as_float(zz[j] << 16), __uint_as_float(uu[j] & 0xffff0000u) * __uint_as_float(zz[j] & 0xffff0000u));
        uint4 ov; ov.x = oo[0]; ov.y = oo[1]; ov.z = oo[2]; ov.w = oo[3];
        *(uint4*)pz = ov;
      }
    }
    __syncthreads();
  }
}
DI_ void mla_uv_phase(const bf16_t* Qp, const bf16_t* WuvT, bf16_t* Z, bf16_t* smem) {
  TILE_IDS(); CFG_B();
  for (int t = blockIdx.x; t < 64 * 16; t += gridDim.x) {
    const int mt = t >> 4, h = t & 15;
    GemmArgs g{Qp + (size_t)mt * 256 * 3072 + h * 192, 3072, nullptr, 0, 1 << 30, WuvT + (size_t)h * 128 * 128, 128, 2};
    f32x16 acc[MI][NI];
    gemm_mainloop<WM, WN, MI, NI>(g, smem, acc);
    {
      bf16_t* st = wave_stage<64>(smem, w);
      bf16_t* gp = Z + (size_t)(mt * 256 + wm * 64) * DIN + h * 128 + wn * 64;
      stage_load<64, 64>(st, gp, DIN, lane);
#pragma unroll
      for (int mi = 0; mi < MI; ++mi)
#pragma unroll
        for (int ni = 0; ni < NI; ++ni)
#pragma unroll
          for (int i = 0; i < 16; ++i) {
            bf16_t* pz = st + (mi * 32 + crow(i, hf)) * LDS_STRIDE + ni * 32 + r;
            *pz = f2bf(acc[mi][ni][i] * bf2f(*pz));
          }
      stage_flush<64, 64>(st, gp, DIN, lane);
    }
  }
}

#define XB_TMO      128
#define XB_XCNT(j)  (256  + 64 * (j))
#define XB_XSUB(j)  (1280 + 64 * (j))
#define XB_XGEN(j)  (2304 + 64 * (j))
#define XB_TOP      3328
#define XB_TOPGEN   3392
#define XCD_BAR_WORDS 3456
#define XB_SPIN_CAP (1u << 18)
#define LAS __attribute__((address_space(3)))
DI_ unsigned xb_ld(unsigned* p)              { return __hip_atomic_load(p, __ATOMIC_RELAXED, __HIP_MEMORY_SCOPE_AGENT); }
DI_ unsigned xb_add(unsigned* p, unsigned v) { return __hip_atomic_fetch_add(p, v, __ATOMIC_RELAXED, __HIP_MEMORY_SCOPE_AGENT); }
DI_ unsigned xb_xcc_id() { return (unsigned)__builtin_amdgcn_s_getreg((3 << 11) | 20) & 0xFu; }
#define XB_SPIN(cond, bar) do { unsigned _sp = 0; while (cond) { __builtin_amdgcn_s_sleep(1); \
    if ((++_sp & 255u) == 0u) { if (xb_ld(&(bar)[XB_TMO])) break; if (_sp > XB_SPIN_CAP) { atomicAdd(&(bar)[XB_TMO], 1u); break; } } } } while (0)
struct XcdBarrier { unsigned* bar; unsigned x; volatile LAS unsigned* st; };
DI_ XcdBarrier xcd_barrier_post(unsigned* bar, volatile LAS unsigned* st) {
  XcdBarrier b; b.bar = bar; b.x = xb_xcc_id(); b.st = st;
  if (threadIdx.x == 0) (void)xb_add(&bar[XB_XCNT(b.x)], 1u);
  return b;
}
DI_ void xcd_barrier_complete(unsigned* bar, unsigned x, unsigned& nloc, unsigned& nx) {
  const unsigned G = gridDim.x * gridDim.y * gridDim.z;
  unsigned sum, cnt, mine, sp = 0u;
  for (;;) {
    sum = 0u; cnt = 0u; mine = 0u;
#pragma unroll
    for (unsigned j = 0; j < 16; ++j) { const unsigned c = xb_ld(&bar[XB_XCNT(j)]); sum += c; cnt += (c > 0u) ? 1u : 0u; mine = (j == x) ? c : mine; }
    if (sum == G) break;
    __builtin_amdgcn_s_sleep(1);
    if ((++sp & 255u) == 0u) { if (xb_ld(&bar[XB_TMO])) break; if (sp > XB_SPIN_CAP) { atomicAdd(&bar[XB_TMO], 1u); break; } }
  }
  nloc = mine > 0u ? mine : 1u; nx = cnt > 0u ? cnt : 1u;
}
DI_ void xcd_barrier(const XcdBarrier& b) {
  asm volatile("s_waitcnt vmcnt(0)" ::: "memory");
  __syncthreads();
  if (threadIdx.x == 0) {
    unsigned* bar = b.bar;
    __builtin_amdgcn_s_waitcnt(0);
    unsigned nloc = b.st[0], nx = b.st[1];
    if (nloc == 0u) { xcd_barrier_complete(bar, b.x, nloc, nx); b.st[0] = nloc; b.st[1] = nx; }
    const unsigned old = xb_add(&bar[XB_XSUB(b.x)], 1u);
    const unsigned gen = old / nloc;
    if (old + 1u == (gen + 1u) * nloc) {
      __builtin_amdgcn_fence(__ATOMIC_RELEASE, "agent");
      asm volatile("s_waitcnt vmcnt(0)" ::: "memory");
      const unsigned og = xb_add(&bar[XB_TOP], 1u);
      const unsigned tg = og / nx;
      if (og + 1u == (tg + 1u) * nx) xb_add(&bar[XB_TOPGEN], 1u);
      else XB_SPIN(xb_ld(&bar[XB_TOPGEN]) == tg, bar);
      __builtin_amdgcn_fence(__ATOMIC_ACQUIRE, "agent");
      xb_add(&bar[XB_XGEN(b.x)], 1u);
      asm volatile("s_waitcnt vmcnt(0)" ::: "memory");
    } else {
      XB_SPIN(xb_ld(&bar[XB_XGEN(b.x)]) == gen, bar);
      __builtin_amdgcn_fence(__ATOMIC_ACQUIRE, "agent");
      asm volatile("s_waitcnt vmcnt(0)" ::: "memory");
    }
  }
  __syncthreads();
}

constexpr int NPHASE = 23;

DI_ void gmlp_pre(const Params& p, int base, const float* hsrc, bf16_t* smem) {
  unsigned char* ws = p.ws;
  convT_phase<MAP_GMLP>(p.in[base + 1], 1024, 6144, 6144, p.in[base + 0], (bf16_t*)(ws + W_OFF), (float*)smem);
  convT_phase<MAP_IDENT>(p.in[base + 6], 2048, 1024, 1024, nullptr, (bf16_t*)(ws + W_OFF + 12 * MiB), (float*)smem);
  rownorm_phase(hsrc, (bf16_t*)(ws + HB_OFF));
}

__global__ void __launch_bounds__(512, 2) mega_kernel(Params p, int ph_lo, int ph_hi) {
  extern __shared__ __attribute__((aligned(16))) unsigned char smem_raw[];
  bf16_t* smem = (bf16_t*)smem_raw;
  cg::grid_group grid = cg::this_grid();
  volatile LAS unsigned* xbst = (volatile LAS unsigned*)(smem_raw + SMEM_MAIN + 2048);
  if (threadIdx.x == 0) { xbst[0] = 0u; xbst[1] = 0u; }
  __syncthreads();
  XcdBarrier xb = xcd_barrier_post((unsigned*)(p.ws + BAR_OFF), xbst);
  if (ph_lo < 0) grid.sync();
#define WSP(T, off) ((T*)(p.ws + (size_t)(off)))
#define HB WSP(bf16_t, HB_OFF)
#define B1 WSP(bf16_t, B1_OFF)
#define B2 WSP(bf16_t, B2_OFF)
#define B3 WSP(bf16_t, B3_OFF)
#define gWin WSP(bf16_t, W_OFF)
#define gWout WSP(bf16_t, W_OFF + 12 * MiB)
#define sWin WSP(bf16_t, W_OFF)
#define sWg WSP(bf16_t, 8 * MiB)
#define sYg WSP(bf16_t, 16 * MiB)
#define sWglu WSP(bf16_t, 40 * MiB)
#define sWout WSP(bf16_t, 48 * MiB)
#define sLam WSP(float, 52 * MiB)
#define mWin WSP(bf16_t, W_OFF)
#define mWq WSP(bf16_t, 6 * MiB)
#define mWuv WSP(bf16_t, 9 * MiB)
#define mWout WSP(bf16_t, 10 * MiB)
#define mCq WSP(bf16_t, 14 * MiB)
#define mCkv WSP(float, 26 * MiB)
#define mKc WSP(bf16_t, 34 * MiB)
#define mKcT WSP(bf16_t, 40 * MiB)
#define mQssq WSP(float, 44 * MiB)
#define mCos WSP(float, 45 * MiB)
#define mSin WSP(float, 47 * MiB)
#define mQp B1
#define mZ WSP(bf16_t, 192 * MiB)
#define h (p.out)

#ifndef ONLY
#define ONLY -1
#endif
#ifndef OLO
#define OLO 0
#define OHI 99
#endif
#ifndef EXCL
#define EXCL -1
#endif
#define PH(n) if ((ONLY < 0 || ONLY == n) && (n >= OLO && n <= OHI) && n != EXCL && ph_lo <= n && n < ph_hi)
#define SY(n) if (ph_lo <= n && n + 1 < ph_hi) xcd_barrier(xb);
  PH(0) {
    gmlp_pre(p, 2, p.in[0], smem);
  }
  SY(0)
  PH(1) {
    gmlp_in_phase(HB, gWin, B1, B2, (float*)B3, smem);
  }
  SY(1)
  PH(2) {
    gmlp_gate_phase(p.in[6], p.in[7], p.in[4], p.in[5], B2, (const float*)B3, B1, smem);
  }
  SY(2)
  PH(3) {
    out_phase(B1, gWout, p.in[0], h, smem);
  }
  SY(3)
  PH(4) {
    convT_phase<MAP_IDENT>(p.in[10], 1024, 4096, 4096, p.in[9], sWin, (float*)smem);
        convT_phase<MAP_IDENT>(p.in[19], 2048, 2048, 2048, nullptr, sWglu, (float*)smem);
        convT_phase<MAP_IDENT>(p.in[21], 2048, 1024, 1024, nullptr, sWout, (float*)smem);
        ssm_pre_phase(p, (float*)smem, sWg, sYg, sLam);
        rownorm_phase(h, HB);
  }
  SY(4)
  PH(5) {
    s5_inu_phase(HB, sWin, B1, smem);
  }
  SY(5)
  PH(6) {
    s5_sgemm_phase(B1, sWg, sLam, B3, sYg, B2, smem);
  }
  SY(6)
  PH(10) {
    s5_glu_phase(HB, sWin + (size_t)2048 * DM, B2, sWglu, p.in[20], B1, smem);
  }
  SY(10)
  PH(11) {
    out_phase(B1, sWout, h, h, smem);
  }
  SY(11)
  PH(12) {
    convT_phase<MAP_MLA>(p.in[23], 1024, 2624, 2816, p.in[22], mWin, (float*)smem);
        convT_phase<MAP_UV>(p.in[27], 128, 4096, 2048, p.in[26], mWuv, (float*)smem);
        convT_phase<MAP_IDENT>(p.in[28], 2048, 1024, 1024, nullptr, mWout, (float*)smem);
        mla_wq_phase(p.in[25], p.in[27], p.in[24], p.in[26], mWq, (float*)smem);
        rope_table_phase((const int*)p.in[1], mCos, mSin);
        rownorm_phase(h, HB);
  }
  SY(12)
  PH(13) {
    mla_in_phase(HB, mWin, mCq, mQssq, mCkv, mKc, mZ, mCos, mSin, smem);
  }
  SY(13)
  PH(14) {
    mla_q_phase(mCq, mQssq, mWq, mQp, mCos, mSin, mCkv, mKc, mKcT, smem);
  }
  SY(14)
  PH(15) {
    mla_attn_phase(mQp, mKc, mKcT, mWuv, mZ, smem);
  }
  SY(15)
  PH(17) {
    out_phase(mZ, mWout, h, h, smem);
  }
  SY(17)
  PH(18) {
    gmlp_pre(p, 29, h, smem);
  }
  SY(18)
  PH(19) {
    gmlp_in_phase(HB, gWin, B1, B2, (float*)B3, smem);
  }
  SY(19)
  PH(20) {
    gmlp_gate_phase(p.in[33], p.in[34], p.in[31], p.in[32], B2, (const float*)B3, B1, smem);
  }
  SY(20)
  PH(21) {
    out_phase(B1, gWout, h, h, smem);
  }
  SY(21)
  PH(22) {
    finalnorm_phase(h, p.in[36]);
  }
  SY(22)
}

extern "C" void kernel_launch(void* const* d_in, const int* in_sizes, int n_in, void* d_out, int out_size, void* d_ws, size_t ws_size,
                              hipStream_t stream) {
  static int grid_blocks = 0;
  if (!grid_blocks) {
    int dev = 0, cus = 0, per_cu = 0;
    hipGetDevice(&dev);
    hipDeviceGetAttribute(&cus, hipDeviceAttributeMultiprocessorCount, dev);
    hipFuncSetAttribute((const void*)mega_kernel, hipFuncAttributeMaxDynamicSharedMemorySize, SMEM_BYTES);
    hipOccupancyMaxActiveBlocksPerMultiprocessor(&per_cu, (const void*)mega_kernel, NT, SMEM_BYTES);
    if (per_cu > 1) per_cu = 1;
    if (per_cu < 1) per_cu = 1;
    grid_blocks = cus * per_cu;
  }
  Params p{};
  for (int i = 0; i < 37 && i < n_in; ++i) p.in[i] = (const float*)d_in[i];
  p.out = (float*)d_out;
  p.ws = (unsigned char*)d_ws;
  hipMemsetAsync((unsigned char*)d_ws + BAR_OFF, 0, XCD_BAR_WORDS * 4, stream);
  int lo = 0, hi = NPHASE;
  void* args[] = {&p, &lo, &hi};
  hipError_t e = hipLaunchCooperativeKernel((const void*)mega_kernel, dim3(grid_blocks), dim3(NT), args, SMEM_BYTES, stream);
  if (e != hipSuccess) fprintf(stderr, "cooperative launch failed: %s (grid %d)\n", hipGetErrorString(e), grid_blocks);
}
```

```cpp
#include <hip/hip_runtime.h>
#include <hip/hip_cooperative_groups.h>
#include <stdint.h>
#include <stdio.h>
namespace cg = cooperative_groups;

typedef unsigned short bf16_t;
typedef __attribute__((ext_vector_type(8))) short bf16x8;
typedef __attribute__((ext_vector_type(16))) float f32x16;
typedef __attribute__((ext_vector_type(4))) unsigned u32x4;

#define DI_ __device__ __forceinline__
#define MFMA32(a, b, c) __builtin_amdgcn_mfma_f32_32x32x16_bf16((a), (b), (c), 0, 0, 0)

constexpr int T_TOK = 16384;
constexpr int DM = 1024;
constexpr int DIN = 2048;
constexpr int SEQ = 4096;
constexpr int LDS_STRIDE = 72;
constexpr int TILE_E = 128 * LDS_STRIDE;
constexpr int NT = 512;
constexpr int SMEM_MAIN = 2 * 512 * LDS_STRIDE * 2;
constexpr int SMEM_BYTES = SMEM_MAIN + 2048 + 16;
constexpr size_t BAR_OFF = 62ull << 20;
constexpr size_t MiB = 1ull << 20;

constexpr size_t W_OFF = 0, HB_OFF = 64 * MiB, B1_OFF = 96 * MiB, B2_OFF = 160 * MiB, B3_OFF = 224 * MiB;

struct Params {
  const float* in[37];
  float* out;
  unsigned char* ws;
};

__device__ const float INVF[32] = {
  1.000000000e+00f, 7.498942614e-01f, 5.623413324e-01f, 4.216965139e-01f, 3.162277639e-01f, 2.371373773e-01f, 1.778279394e-01f, 1.333521307e-01f,
  1.000000015e-01f, 7.498941571e-02f, 5.623413250e-02f, 4.216965288e-02f, 3.162277490e-02f, 2.371373773e-02f, 1.778279431e-02f, 1.333521493e-02f,
  9.999999776e-03f, 7.498941850e-03f, 5.623413250e-03f, 4.216964822e-03f, 3.162277630e-03f, 2.371373586e-03f, 1.778279431e-03f, 1.333521446e-03f,
  1.000000047e-03f, 7.498942432e-04f, 5.623413017e-04f, 4.216965172e-04f, 3.162277571e-04f, 2.371373703e-04f, 1.778279402e-04f, 1.333521504e-04f};

typedef float f32x2 __attribute__((ext_vector_type(2)));
typedef __bf16 bf16x2_t __attribute__((ext_vector_type(2)));
DI_ unsigned short f2bf(float x) { __bf16 h = (__bf16)x; return __builtin_bit_cast(unsigned short, h); }
DI_ float bf2f(unsigned short b) { return __uint_as_float(((unsigned)b) << 16); }
DI_ unsigned pack2(float a, float b) { f32x2 v; v[0] = a; v[1] = b; return __builtin_bit_cast(unsigned, __builtin_convertvector(v, bf16x2_t)); }
DI_ float sigmoidf_(float x) { return __builtin_amdgcn_rcpf(1.f + __expf(-x)); }
DI_ float siluf_(float x) { return x * sigmoidf_(x); }
DI_ float geluf_(float x) { float y = 1.5957691216057308f * (x + 0.044715f * x * x * x); return x * sigmoidf_(y); }
DI_ int crow(int i, int hf) { return (i & 3) + 8 * (i >> 2) + 4 * hf; }
DI_ float red32(float v) { v += __shfl_xor(v, 1); v += __shfl_xor(v, 2); v += __shfl_xor(v, 4); v += __shfl_xor(v, 8); v += __shfl_xor(v, 16); return v; }
DI_ float red64(float v) { v = red32(v); v += __shfl_xor(v, 32); return v; }
DI_ void sincos_red(float x, float* s, float* c) {
  double xd = (double)x;
  double k = rint(xd * 0.15915494309189535);
  float r = (float)(xd - k * 6.283185307179586);
  *s = __sinf(r); *c = __cosf(r);
}

struct GemmArgs {
  const bf16_t* A1; int lda1;
  const bf16_t* A2; int lda2; int kt_split;
  const bf16_t* Bt; int ldb; int nkt;
};

template <int WM, int WN, int MI, int NI>
DI_ void gemm_compute_sw(const bf16_t* As, const bf16_t* Bs, int wm, int wn, int r, int hf, f32x16 (&acc)[MI][NI]) {
  bf16x8 a[2][MI], b[2][NI];
  int ao[MI], ax[MI], bo[NI], bx[NI];
#pragma unroll
  for (int mi = 0; mi < MI; ++mi) { const int R = wm * MI * 32 + mi * 32 + r; ao[mi] = R * 64; ax[mi] = (R >> 1) & 7; }
#pragma unroll
  for (int ni = 0; ni < NI; ++ni) { const int R = wn * NI * 32 + ni * 32 + r; bo[ni] = R * 64; bx[ni] = (R >> 1) & 7; }
#pragma unroll
  for (int mi = 0; mi < MI; ++mi) a[0][mi] = *(const bf16x8*)(As + ao[mi] + ((hf ^ ax[mi]) * 8));
#pragma unroll
  for (int ni = 0; ni < NI; ++ni) b[0][ni] = *(const bf16x8*)(Bs + bo[ni] + ((hf ^ bx[ni]) * 8));
#pragma unroll
  for (int ks = 0; ks < 4; ++ks) {
    if (ks < 3) {
#pragma unroll
      for (int mi = 0; mi < MI; ++mi) a[(ks + 1) & 1][mi] = *(const bf16x8*)(As + ao[mi] + ((((ks + 1) * 2 + hf) ^ ax[mi]) * 8));
#pragma unroll
      for (int ni = 0; ni < NI; ++ni) b[(ks + 1) & 1][ni] = *(const bf16x8*)(Bs + bo[ni] + ((((ks + 1) * 2 + hf) ^ bx[ni]) * 8));
    }
#pragma unroll
    for (int mi = 0; mi < MI; ++mi)
#pragma unroll
      for (int ni = 0; ni < NI; ++ni) acc[mi][ni] = MFMA32(a[ks & 1][mi], b[ks & 1][ni], acc[mi][ni]);
    __builtin_amdgcn_sched_barrier(0);
  }
}

template <int WM, int WN, int MI, int NI>
DI_ void gemm_compute(const bf16_t* As, const bf16_t* Bs, int wm, int wn, int r, int hf, f32x16 (&acc)[MI][NI]) {
#pragma unroll
  for (int ks = 0; ks < 4; ++ks) {
    bf16x8 a[MI], b[NI];
#pragma unroll
    for (int mi = 0; mi < MI; ++mi) a[mi] = *(const bf16x8*)(As + (wm * MI * 32 + mi * 32 + r) * LDS_STRIDE + ks * 16 + hf * 8);
#pragma unroll
    for (int ni = 0; ni < NI; ++ni) b[ni] = *(const bf16x8*)(Bs + (wn * NI * 32 + ni * 32 + r) * LDS_STRIDE + ks * 16 + hf * 8);
#pragma unroll
    for (int mi = 0; mi < MI; ++mi)
#pragma unroll
      for (int ni = 0; ni < NI; ++ni) acc[mi][ni] = MFMA32(a[mi], b[ni], acc[mi][ni]);
  }
}

template <int WM, int WN, int MI, int NI, bool ZERO = true>
DI_ void gemm_mainloop(const GemmArgs& g, bf16_t* smem, f32x16 (&acc)[MI][NI]) {
  constexpr int BM = WM * MI * 32, BN = WN * NI * 32;
  constexpr int ATILE = BM * 64, STAGE = (BM + BN) * 64;
  constexpr int ACH = BM / 64, BCH = BN / 64, NPC = ACH + BCH, PPK = (NPC + 1) / 2;
  int tid_ = threadIdx.x; asm volatile("" : "+v"(tid_));
  const int tid = tid_, lane = tid & 63, w = tid >> 6, wm = w / WN, wn = w % WN;
  const int r = lane & 31, hf = lane >> 5;
  const int lrow = tid >> 3;
  const int gc = ((tid & 7) ^ ((lrow >> 1) & 7)) * 8;
  if (ZERO) {
#pragma unroll
    for (int mi = 0; mi < MI; ++mi)
#pragma unroll
      for (int ni = 0; ni < NI; ++ni)
#pragma unroll
        for (int i = 0; i < 16; ++i) acc[mi][ni][i] = 0.f;
  }
  const int key = (r >> 1) & 7;
  const int abase = (wm * MI * 32 + r) * 64, bbase = ATILE + (wn * NI * 32 + r) * 64;
  const int koff0 = ((0 + hf) ^ key) * 8, koff1 = ((2 + hf) ^ key) * 8, koff2 = ((4 + hf) ^ key) * 8, koff3 = ((6 + hf) ^ key) * 8;
  __syncthreads();
  {
    const bf16_t* a; int lda;
    if (0 < g.kt_split) { a = g.A1; lda = g.lda1; } else { a = g.A2; lda = g.lda2; }
    const int toffa = lrow * lda + gc, toffb = lrow * g.ldb + gc;
#pragma unroll
    for (int i = 0; i < ACH; ++i)
      __builtin_amdgcn_global_load_lds((const unsigned*)(a + (size_t)i * 64 * lda + toffa), (unsigned*)(smem + (i * NT + tid) * 8), 16, 0, 0);
#pragma unroll
    for (int i = 0; i < BCH; ++i)
      __builtin_amdgcn_global_load_lds((const unsigned*)(g.Bt + (size_t)i * 64 * g.ldb + toffb), (unsigned*)(smem + ATILE + (i * NT + tid) * 8), 16, 0, 0);
  }
  __syncthreads();
  bf16x8 a[2][MI], b[2][NI];
#pragma unroll
  for (int mi = 0; mi < MI; ++mi) a[0][mi] = *(const bf16x8*)(smem + abase + mi * 2048 + koff0);
#pragma unroll
  for (int ni = 0; ni < NI; ++ni) b[0][ni] = *(const bf16x8*)(smem + bbase + ni * 2048 + koff0);
  for (int kt = 0; kt < g.nkt; ++kt) {
    const bool more = (kt + 1 < g.nkt);
    const int k1 = kt + 1;
    const bf16_t* an; int ldan;
    if (k1 < g.kt_split) { an = g.A1 + k1 * 64; ldan = g.lda1; } else { an = g.A2 + (k1 - g.kt_split) * 64; ldan = g.lda2; }
    const bf16_t* bn = g.Bt + k1 * 64;
    const int toffa = lrow * ldan + gc, toffb = lrow * g.ldb + gc;
    bf16_t* Sn = smem + (k1 & 1) * STAGE;
    const bf16_t* Sc = smem + (kt & 1) * STAGE;
#pragma unroll
    for (int ks = 0; ks < 4; ++ks) {
      if (more) {
#pragma unroll
        for (int q = 0; q < PPK; ++q) {
          const int j = ks * PPK + q;
          if (j < ACH)
            __builtin_amdgcn_global_load_lds((const unsigned*)(an + (size_t)j * 64 * ldan + toffa), (unsigned*)(Sn + (j * NT + tid) * 8), 16, 0, 0);
          else if (j < NPC)
            __builtin_amdgcn_global_load_lds((const unsigned*)(bn + (size_t)(j - ACH) * 64 * g.ldb + toffb), (unsigned*)(Sn + ATILE + ((j - ACH) * NT + tid) * 8), 16, 0, 0);
        }
      }
      if (ks < 3) {
        const int ko = (ks == 0) ? koff1 : (ks == 1) ? koff2 : koff3;
#pragma unroll
        for (int mi = 0; mi < MI; ++mi) a[(ks + 1) & 1][mi] = *(const bf16x8*)(Sc + abase + mi * 2048 + ko);
#pragma unroll
        for (int ni = 0; ni < NI; ++ni) b[(ks + 1) & 1][ni] = *(const bf16x8*)(Sc + bbase + ni * 2048 + ko);
      } else {
        __syncthreads();
        if (more) {
#pragma unroll
          for (int mi = 0; mi < MI; ++mi) a[0][mi] = *(const bf16x8*)(Sn + abase + mi * 2048 + koff0);
#pragma unroll
          for (int ni = 0; ni < NI; ++ni) b[0][ni] = *(const bf16x8*)(Sn + bbase + ni * 2048 + koff0);
        }
      }
      __builtin_amdgcn_sched_barrier(0);
#pragma unroll
      for (int mi = 0; mi < MI; ++mi)
#pragma unroll
        for (int ni = 0; ni < NI; ++ni) acc[mi][ni] = MFMA32(a[ks & 1][mi], b[ks & 1][ni], acc[mi][ni]);
      __builtin_amdgcn_sched_barrier(0);
    }
  }
}

typedef __attribute__((ext_vector_type(4))) float f32x4;
#define MFMA16(a, b, c) __builtin_amdgcn_mfma_f32_16x16x32_bf16((a), (b), (c), 0, 0, 0)
template <int WM, int WN, int MT, int NQ>
DI_ void gemm_mainloop16(const GemmArgs& gr, bf16_t* smem, f32x4 (&acc)[MT][NQ]) {
  struct { const bf16_t* A1; int lda1; const bf16_t* A2; int lda2; int kt_split; const bf16_t* Bt; int ldb; int nkt; } g;
  g.A1 = gr.A1; g.lda1 = gr.lda1; g.A2 = gr.A2 ? gr.A2 : gr.A1; g.lda2 = gr.A2 ? gr.lda2 : gr.lda1; g.kt_split = gr.kt_split; g.Bt = gr.Bt; g.ldb = gr.ldb; g.nkt = gr.nkt;
  constexpr int BM = WM * MT * 16, BN = WN * NQ * 16;
  constexpr int ATILE = BM * 64, STAGE = (BM + BN) * 64;
  constexpr int ACH = BM / 64, BCH = BN / 64, NPC = ACH + BCH, PPK = (NPC + 1) / 2;
  int tid_ = threadIdx.x; asm volatile("" : "+v"(tid_));
  const int tid = tid_, lane = tid & 63, w = tid >> 6, wm = w / WN, wn = w % WN;
  const int r16 = lane & 15, quad = lane >> 4;
  const int lrow = tid >> 3;
  const int gc = ((tid & 7) ^ ((lrow >> 1) & 7)) * 8;
#pragma unroll
  for (int mt = 0; mt < MT; ++mt)
#pragma unroll
    for (int nq = 0; nq < NQ; ++nq)
#pragma unroll
      for (int j = 0; j < 4; ++j) acc[mt][nq][j] = 0.f;
  const int key = (r16 >> 1) & 7;
  const int abase = (wm * MT * 16 + r16) * 64, bbase = ATILE + (wn * NQ * 16 + r16) * 64;
  const int koff0 = ((0 + quad) ^ key) * 8, koff1 = ((4 + quad) ^ key) * 8;
  __syncthreads();
  {
    const bf16_t* a0 = (0 < g.kt_split) ? g.A1 : g.A2;
    const int lda0 = (0 < g.kt_split) ? g.lda1 : g.lda2;
    const int toffa = lrow * lda0 + gc, toffb = lrow * g.ldb + gc;
#pragma unroll
    for (int i = 0; i < ACH; ++i)
      __builtin_amdgcn_global_load_lds((const unsigned*)(a0 + (size_t)i * 64 * lda0 + toffa), (unsigned*)(smem + (i * NT + tid) * 8), 16, 0, 0);
#pragma unroll
    for (int i = 0; i < BCH; ++i)
      __builtin_amdgcn_global_load_lds((const unsigned*)(g.Bt + (size_t)i * 64 * g.ldb + toffb), (unsigned*)(smem + ATILE + (i * NT + tid) * 8), 16, 0, 0);
  }
  __syncthreads();
#pragma unroll 1
  for (int kt = 0; kt < g.nkt; ++kt) {
    const bool more = (kt + 1 < g.nkt);
    const int k1 = kt + 1;
    const bool first = k1 < g.kt_split;
    const bf16_t* an = (first ? g.A1 : g.A2) + (first ? k1 : k1 - g.kt_split) * 64;
    const int ldan = first ? g.lda1 : g.lda2;
    const bf16_t* bn = g.Bt + k1 * 64;
    const int toffa = lrow * ldan + gc, toffb = lrow * g.ldb + gc;
    bf16_t* Sn = smem + (k1 & 1) * STAGE;
    const bf16_t* Sc = smem + (kt & 1) * STAGE;
    __builtin_amdgcn_iglp_opt(0);
#pragma unroll
    for (int ks = 0; ks < 2; ++ks) {
      if (more) {
#pragma unroll
        for (int q = 0; q < PPK; ++q) {
          const int j = ks * PPK + q;
          if (j < ACH)
            __builtin_amdgcn_global_load_lds((const unsigned*)(an + (size_t)j * 64 * ldan + toffa), (unsigned*)(Sn + (j * NT + tid) * 8), 16, 0, 0);
          else if (j < NPC)
            __builtin_amdgcn_global_load_lds((const unsigned*)(bn + (size_t)(j - ACH) * 64 * g.ldb + toffb), (unsigned*)(Sn + ATILE + ((j - ACH) * NT + tid) * 8), 16, 0, 0);
        }
      }
      const int ko = ks ? koff1 : koff0;
      bf16x8 a[MT], b[NQ];
#pragma unroll
      for (int mt = 0; mt < MT; ++mt) a[mt] = *(const bf16x8*)(Sc + abase + mt * 1024 + ko);
#pragma unroll
      for (int nq = 0; nq < NQ; ++nq) b[nq] = *(const bf16x8*)(Sc + bbase + nq * 1024 + ko);
#pragma unroll
      for (int mt = 0; mt < MT; ++mt)
#pragma unroll
        for (int nq = 0; nq < NQ; ++nq) acc[mt][nq] = MFMA16(a[mt], b[nq], acc[mt][nq]);
    }
    __syncthreads();
  }
}

template <int WM, int WN, int MT, int NQ>
DI_ void gemm_mainloop16s(const GemmArgs& gr, bf16_t* smem, f32x4 (&acc)[MT][NQ]) {
  struct { const bf16_t* A1; int lda1; const bf16_t* A2; int lda2; int kt_split; const bf16_t* Bt; int ldb; int nkt; } g;
  g.A1 = gr.A1; g.lda1 = gr.lda1; g.A2 = gr.A2 ? gr.A2 : gr.A1; g.lda2 = gr.A2 ? gr.lda2 : gr.lda1; g.kt_split = gr.kt_split; g.Bt = gr.Bt; g.ldb = gr.ldb; g.nkt = gr.nkt;
  constexpr int BM = WM * MT * 16, BN = WN * NQ * 16;
  constexpr int ATILE = BM * 64, STAGE = (BM + BN) * 64;
  constexpr int ACH = BM / 64, BCH = BN / 64, NPC = ACH + BCH, PPK = (NPC + 1) / 2;
  int tid_ = threadIdx.x; asm volatile("" : "+v"(tid_));
  const int tid = tid_, lane = tid & 63, w = tid >> 6, wm = w / WN, wn = w % WN;
  const int r16 = lane & 15, quad = lane >> 4;
  const int lrow = tid >> 3;
  const int gc = ((tid & 7) ^ ((lrow >> 1) & 7)) * 8;
#pragma unroll
  for (int mt = 0; mt < MT; ++mt)
#pragma unroll
    for (int nq = 0; nq < NQ; ++nq)
#pragma unroll
      for (int j = 0; j < 4; ++j) acc[mt][nq][j] = 0.f;
  const int key = (r16 >> 1) & 7;
  const int abase = (wm * MT * 16 + r16) * 64, bbase = ATILE + (wn * NQ * 16 + r16) * 64;
  const int koff0 = ((0 + quad) ^ key) * 8, koff1 = ((4 + quad) ^ key) * 8;
  __syncthreads();
  {
    const bf16_t* a0 = (0 < g.kt_split) ? g.A1 : g.A2;
    const int lda0 = (0 < g.kt_split) ? g.lda1 : g.lda2;
    const int toffa = lrow * lda0 + gc, toffb = lrow * g.ldb + gc;
#pragma unroll
    for (int i = 0; i < ACH; ++i)
      __builtin_amdgcn_global_load_lds((const unsigned*)(a0 + (size_t)i * 64 * lda0 + toffa), (unsigned*)(smem + (i * NT + tid) * 8), 16, 0, 0);
#pragma unroll
    for (int i = 0; i < BCH; ++i)
      __builtin_amdgcn_global_load_lds((const unsigned*)(g.Bt + (size_t)i * 64 * g.ldb + toffb), (unsigned*)(smem + ATILE + (i * NT + tid) * 8), 16, 0, 0);
  }
  __syncthreads();
#pragma unroll 1
  for (int kt = 0; kt < g.nkt; ++kt) {
    const bool more = (kt + 1 < g.nkt);
    const int k1 = kt + 1;
    const bool first = k1 < g.kt_split;
    const bf16_t* an = (first ? g.A1 : g.A2) + (first ? k1 : k1 - g.kt_split) * 64;
    const int ldan = first ? g.lda1 : g.lda2;
    const bf16_t* bn = g.Bt + k1 * 64;
    const int toffa = lrow * ldan + gc, toffb = lrow * g.ldb + gc;
    bf16_t* Sn = smem + (k1 & 1) * STAGE;
    const bf16_t* Sc = smem + (kt & 1) * STAGE;
#pragma unroll
    for (int ks = 0; ks < 2; ++ks) {
      if (more) {
#pragma unroll
        for (int q = 0; q < PPK; ++q) {
          const int j = ks * PPK + q;
          if (j < ACH)
            __builtin_amdgcn_global_load_lds((const unsigned*)(an + (size_t)j * 64 * ldan + toffa), (unsigned*)(Sn + (j * NT + tid) * 8), 16, 0, 0);
          else if (j < NPC)
            __builtin_amdgcn_global_load_lds((const unsigned*)(bn + (size_t)(j - ACH) * 64 * g.ldb + toffb), (unsigned*)(Sn + ATILE + ((j - ACH) * NT + tid) * 8), 16, 0, 0);
        }
      }
      const int ko = ks ? koff1 : koff0;
      bf16x8 a[MT], b[NQ];
#pragma unroll
      for (int mt = 0; mt < MT; ++mt) a[mt] = *(const bf16x8*)(Sc + abase + mt * 1024 + ko);
#pragma unroll
      for (int nq = 0; nq < NQ; ++nq) b[nq] = *(const bf16x8*)(Sc + bbase + nq * 1024 + ko);
#pragma unroll
      for (int mt = 0; mt < MT; ++mt)
#pragma unroll
        for (int nq = 0; nq < NQ; ++nq) acc[mt][nq] = MFMA16(a[mt], b[nq], acc[mt][nq]);
      __builtin_amdgcn_sched_barrier(0);
    }
    __syncthreads();
  }
}

template <int ROWS> DI_ bf16_t* wave_stage(bf16_t* smem, int w) { return smem + w * ROWS * LDS_STRIDE; }
DI_ void stage_sync() { asm volatile("s_waitcnt lgkmcnt(0)" ::: "memory"); __builtin_amdgcn_wave_barrier(); }
template <int ROWS, int COLS> DI_ void stage_flush(const bf16_t* st, bf16_t* out, size_t ld, int lane) {
  constexpr int CPR = COLS / 8, RPI = 64 / CPR;
  stage_sync();
#pragma unroll 4
  for (int it = 0; it < ROWS / RPI; ++it) {
    const int row = it * RPI + lane / CPR, ch = lane % CPR;
    const uint4 v = *(const uint4*)(st + row * LDS_STRIDE + ch * 8);
    *(uint4*)(out + (size_t)row * ld + ch * 8) = v;
  }
  stage_sync();
}

template <int ROWS, int COLS> DI_ void stage_load(bf16_t* st, const bf16_t* in, size_t ld, int lane) {
  constexpr int CPR = COLS / 8, RPI = 64 / CPR;
#pragma unroll 4
  for (int it = 0; it < ROWS / RPI; ++it) {
    const int row = it * RPI + lane / CPR, ch = lane % CPR;
    const uint4 v = *(const uint4*)(in + (size_t)row * ld + ch * 8);
    *(uint4*)(st + row * LDS_STRIDE + ch * 8) = v;
  }
  stage_sync();
}
template <int ROWS, class F> DI_ void stage_rowstats(const bf16_t* st, int lane, F f) {
  stage_sync();
#pragma unroll 2
  for (int it = 0; it < ROWS / 8; ++it) {
    const int row = it * 8 + (lane >> 3), ch = lane & 7;
    const uint4 v = *(const uint4*)(st + row * LDS_STRIDE + ch * 8);
    const unsigned u[4] = {v.x, v.y, v.z, v.w};
    float s1 = 0.f, s2 = 0.f;
#pragma unroll
    for (int j = 0; j < 4; ++j) {
      const float a = __uint_as_float(u[j] << 16), b = __uint_as_float(u[j] & 0xffff0000u);
      s1 += a + b; s2 += a * a + b * b;
    }
    s1 += __shfl_xor(s1, 1); s2 += __shfl_xor(s2, 1);
    s1 += __shfl_xor(s1, 2); s2 += __shfl_xor(s2, 2);
    s1 += __shfl_xor(s1, 4); s2 += __shfl_xor(s2, 4);
    if (ch == 0) f(row, s1, s2);
  }
}

#define TILE_IDS() int tid_ = threadIdx.x; asm volatile("" : "+v"(tid_)); const int tid = tid_, lane = tid & 63, w = tid >> 6, r = lane & 31, hf = lane >> 5; (void)tid; (void)w; (void)r; (void)hf;
#define CFG_A() constexpr int WM = 2, WN = 4, MI = 4, NI = 2; const int wm = w / WN, wn = w % WN; (void)wm; (void)wn;
#define CFG_B() constexpr int WM = 4, WN = 2, MI = 2, NI = 2; const int wm = w / WN, wn = w % WN; (void)wm; (void)wn;
#define CFG_A16() constexpr int WM = 2, WN = 4, MT = 8, NQ = 4; const int wm = w / WN, wn = w % WN, r16 = lane & 15, quad = lane >> 4; (void)wm; (void)wn; (void)r16; (void)quad;
#define CFG_B16() constexpr int WM = 4, WN = 2, MT = 4, NQ = 4; const int wm = w / WN, wn = w % WN, r16 = lane & 15, quad = lane >> 4; (void)wm; (void)wn; (void)r16; (void)quad;
#define CFG_C() constexpr int WM = 2, WN = 4, MI = 2, NI = 2; const int wm = w / WN, wn = w % WN; (void)wm; (void)wn;

DI_ int norm_row_map(int rr) {
  return (gridDim.x == 256) ? ((((rr >> 3) & 7) + 8 * (rr >> 11)) << 8) + (((rr >> 6) & 31) << 3) + (rr & 7) : rr;
}
DI_ void rownorm_phase(const float* src, bf16_t* dst) {
  const int lane = threadIdx.x & 63;
  const int gw = blockIdx.x * 8 + (threadIdx.x >> 6), nw = gridDim.x * 8;
  for (int rr0 = gw; rr0 < T_TOK; rr0 += 4 * nw) {
    int row[4]; bool ok[4]; float4 v[4][4]; float ss[4];
#pragma unroll
    for (int k = 0; k < 4; ++k) { const int rr = rr0 + k * nw; ok[k] = rr < T_TOK; row[k] = norm_row_map(ok[k] ? rr : rr0); }
#pragma unroll
    for (int k = 0; k < 4; ++k) {
      const float4* s4 = (const float4*)(src + (size_t)row[k] * DM);
#pragma unroll
      for (int i = 0; i < 4; ++i) v[k][i] = s4[lane + i * 64];
    }
#pragma unroll
    for (int k = 0; k < 4; ++k) {
      float a_ = 0.f;
#pragma unroll
      for (int i = 0; i < 4; ++i) a_ += v[k][i].x * v[k][i].x + v[k][i].y * v[k][i].y + v[k][i].z * v[k][i].z + v[k][i].w * v[k][i].w;
      ss[k] = a_;
    }
#pragma unroll
    for (int k = 0; k < 4; ++k) ss[k] = red64(ss[k]);
#pragma unroll
    for (int k = 0; k < 4; ++k) {
      if (ok[k]) {
        const float rs = rsqrtf(ss[k] * (1.f / 1024.f) + 1e-6f);
#pragma unroll
        for (int i = 0; i < 4; ++i) {
          uint2 o; o.x = pack2(v[k][i].x * rs, v[k][i].y * rs); o.y = pack2(v[k][i].z * rs, v[k][i].w * rs);
          *(uint2*)(dst + (size_t)row[k] * DM + (lane + i * 64) * 4) = o;
        }
      }
    }
  }
}

DI_ void finalnorm_phase(float* h, const float* gain) {
  const int lane = threadIdx.x & 63;
  const int gw = blockIdx.x * 8 + (threadIdx.x >> 6), nw = gridDim.x * 8;
  const float4* g4 = (const float4*)gain;
  float4 gv[4];
#pragma unroll
  for (int i = 0; i < 4; ++i) gv[i] = g4[lane + i * 64];
  for (int rr0 = gw; rr0 < T_TOK; rr0 += 4 * nw) {
    int row[4]; bool ok[4]; float4 v[4][4]; float ss[4];
#pragma unroll
    for (int k = 0; k < 4; ++k) { const int rr = rr0 + k * nw; ok[k] = rr < T_TOK; row[k] = norm_row_map(ok[k] ? rr : rr0); }
#pragma unroll
    for (int k = 0; k < 4; ++k) {
      const float4* s4 = (const float4*)(h + (size_t)row[k] * DM);
#pragma unroll
      for (int i = 0; i < 4; ++i) v[k][i] = s4[lane + i * 64];
    }
#pragma unroll
    for (int k = 0; k < 4; ++k) {
      float a_ = 0.f;
#pragma unroll
      for (int i = 0; i < 4; ++i) a_ += v[k][i].x * v[k][i].x + v[k][i].y * v[k][i].y + v[k][i].z * v[k][i].z + v[k][i].w * v[k][i].w;
      ss[k] = a_;
    }
#pragma unroll
    for (int k = 0; k < 4; ++k) ss[k] = red64(ss[k]);
#pragma unroll
    for (int k = 0; k < 4; ++k) {
      if (ok[k]) {
        const float rs = rsqrtf(ss[k] * (1.f / 1024.f) + 1e-6f);
        float4* o4 = (float4*)(h + (size_t)row[k] * DM);
#pragma unroll
        for (int i = 0; i < 4; ++i) {
          float4 o; o.x = v[k][i].x * rs * gv[i].x; o.y = v[k][i].y * rs * gv[i].y; o.z = v[k][i].z * rs * gv[i].z; o.w = v[k][i].w * rs * gv[i].w;
          o4[lane + i * 64] = o;
        }
      }
    }
  }
}

enum { MAP_IDENT = 0, MAP_GMLP = 1, MAP_MLA = 2, MAP_UV = 3 };
template <int MAP> DI_ int colmap(int n) {
  if (MAP == MAP_IDENT) return n;
  if (MAP == MAP_GMLP) {
    if (n < 4096) { int wt = n >> 6, rr = n & 63; int ch = wt * 32 + (rr & 31); return (rr < 32) ? ch : 4096 + ch; }
    return 2048 + (n - 4096);
  }
  if (MAP == MAP_MLA) { if (n < 576) return n; if (n < 640 || n >= 2688) return -1; return n - 64; }
    return (n >> 7) * 256 + 128 + (n & 127);
}
template <int MAP> DI_ void convT_phase(const float* src, int K, int Nsrc, int Ndst, const float* gain, bf16_t* dst, float* tile) {
  const int tx = threadIdx.x & 63, ty = threadIdx.x >> 6;
  const int nkb = K >> 7, ntiles = nkb * (Ndst >> 6);
  for (int t = blockIdx.x; t < ntiles; t += gridDim.x) {
    const int kb = t % nkb, nb = t / nkb, k0 = kb * 128, n0 = nb * 64;
    const int sc = colmap<MAP>(n0 + tx);
    __syncthreads();
#pragma unroll
    for (int q = 0; q < 16; ++q) {
      const int kk = ty + q * 8;
      float v = (sc >= 0) ? src[(size_t)(k0 + kk) * Nsrc + sc] : 0.f;
      if (gain) v *= gain[k0 + kk];
      tile[kk * 65 + tx] = v;
    }
    __syncthreads();
#pragma unroll
    for (int q = 0; q < 8; ++q) {
      const int nn = ty + q * 8;
      const unsigned o = pack2(tile[(2 * tx) * 65 + nn], tile[(2 * tx + 1) * 65 + nn]);
      *(unsigned*)(dst + (size_t)(n0 + nn) * K + k0 + 2 * tx) = o;
    }
  }
}

DI_ void gmlp_in_phase(const bf16_t* HB, const bf16_t* WinT, bf16_t* UZ, bf16_t* VgT, float* vstat, bf16_t* smem) {
  TILE_IDS(); CFG_A16();
  for (int t = blockIdx.x; t < 64 * 24; t += gridDim.x) {
    const int q_ = t >> 3, mt_ = (t & 7) + 8 * (q_ & 7), nt = 4 * (q_ >> 5) + ((q_ >> 3) & 3);
    GemmArgs g{HB + (size_t)mt_ * 256 * DM, DM, nullptr, 0, 1 << 30, WinT + (size_t)nt * 256 * DM, DM, 16};
    f32x4 acc[MT][NQ];
    gemm_mainloop16<WM, WN, MT, NQ>(g, smem, acc);
    const int cb = nt * 4 + wn;
    bf16_t* st = wave_stage<128>(smem, w);
    if (cb < 64) {
#pragma unroll
      for (int mt = 0; mt < MT; ++mt)
#pragma unroll
        for (int nq = 0; nq < 2; ++nq)
#pragma unroll
          for (int j = 0; j < 4; ++j)
            st[(mt * 16 + quad * 4 + j) * LDS_STRIDE + nq * 16 + r16] = f2bf(geluf_(acc[mt][nq][j]) * siluf_(acc[mt][nq + 2][j]));
      stage_flush<128, 32>(st, UZ + (size_t)(mt_ * 256 + wm * 128) * DIN + cb * 32, DIN, lane);
    } else {
      const int cbv = cb - 64;
#pragma unroll
      for (int mt = 0; mt < MT; ++mt)
#pragma unroll
        for (int nq = 0; nq < NQ; ++nq) {
          const int d = cbv * 64 + nq * 16 + r16;
          const float v0 = geluf_(acc[mt][nq][0]), v1 = geluf_(acc[mt][nq][1]), v2 = geluf_(acc[mt][nq][2]), v3 = geluf_(acc[mt][nq][3]);
          uint2 o; o.x = pack2(v0, v1); o.y = pack2(v2, v3);
          *(uint2*)(VgT + ((size_t)(mt_ * 2 + wm) * DIN + d) * 128 + mt * 16 + quad * 4) = o;
          bf16_t* sp = st + (mt * 16 + quad * 4) * LDS_STRIDE + nq * 16 + r16;
          sp[0] = (bf16_t)(o.x & 0xffffu); sp[LDS_STRIDE] = (bf16_t)(o.x >> 16);
          sp[2 * LDS_STRIDE] = (bf16_t)(o.y & 0xffffu); sp[3 * LDS_STRIDE] = (bf16_t)(o.y >> 16);
        }
      const int rowg = mt_ * 256 + wm * 128;
      stage_rowstats<128>(st, lane, [&](int row, float s1, float s2) {
        float2 o; o.x = s1; o.y = s2;
        *(float2*)(vstat + ((size_t)(rowg + row) * 32 + cbv) * 2) = o;
      });
      stage_sync();
    }
  }
}

DI_ void gmlp_gate_phase(const float* w_s, const float* b_s, const float* ln_g, const float* ln_b,
                         const bf16_t* VgT, const float* vstat, bf16_t* UZ, bf16_t* smem) {
  TILE_IDS(); CFG_C();
  constexpr int ATILE = 128 * LDS_STRIDE, STAGE = 384 * LDS_STRIDE;
  float* ext = (float*)((unsigned char*)smem + SMEM_MAIN);
  for (int item = blockIdx.x; item < 1024; item += gridDim.x) {
    const int xk = item >> 3, g = xk & 7, chunk = (((item & 7) + 8 * (xk >> 4)) << 1) + ((xk >> 3) & 1);
    __syncthreads();
    if (tid < 128) {
      const float2* ps = (const float2*)(vstat + (size_t)(chunk * 128 + tid) * 64);
      float s1 = 0.f, s2 = 0.f;
      for (int j = 0; j < 32; ++j) { float2 v = ps[j]; s1 += v.x; s2 += v.y; }
      const float mu = s1 * (1.f / 2048.f);
      const float var = fmaxf(s2 * (1.f / 2048.f) - mu * mu, 0.f);
      ext[tid] = mu; ext[128 + tid] = rsqrtf(var + 1e-6f);
    }
    __syncthreads();
    {
      const int tp = tid >> 2, q = tid & 3;
      const float4* wrow = (const float4*)(w_s + (size_t)(g * 128 + tp) * 128 + q * 32);
      float r0 = 0.f, r1 = 0.f;
#pragma unroll 1
      for (int j8 = 0; j8 < 4; ++j8) {
        const float4 wa = wrow[j8 * 2], wb = wrow[j8 * 2 + 1];
        const float wv[8] = {wa.x, wa.y, wa.z, wa.w, wb.x, wb.y, wb.z, wb.w};
        float sc[8];
#pragma unroll
        for (int j = 0; j < 8; ++j) {
          const int tk = q * 32 + j8 * 8 + j;
          const float wm_ = (tk <= tp) ? wv[j] : 0.f;
          r0 += wm_;
          sc[j] = bf2f(f2bf(wm_ * ext[128 + tk]));
          r1 += sc[j] * ext[tk];
        }
        uint4 o; o.x = pack2(sc[0], sc[1]); o.y = pack2(sc[2], sc[3]); o.z = pack2(sc[4], sc[5]); o.w = pack2(sc[6], sc[7]);
        const int tk0 = q * 32 + j8 * 8;
        *(uint4*)(smem + (tk0 >> 6) * STAGE + tp * LDS_STRIDE + (tk0 & 63)) = o;
      }
      r0 += __shfl_xor(r0, 1); r0 += __shfl_xor(r0, 2);
      r1 += __shfl_xor(r1, 1); r1 += __shfl_xor(r1, 2);
      if (q == 0) { ext[256 + tp] = r0; ext[384 + tp] = r1; }
    }
#pragma unroll 2
    for (int i = 0; i < 8; ++i) {
      const int c = tid + i * NT, d = c >> 4, kc = c & 15;
      uint4 v = *(const uint4*)(VgT + ((size_t)chunk * DIN + g * 256 + d) * 128 + kc * 8);
      *(uint4*)(smem + (kc >> 3) * STAGE + ATILE + d * LDS_STRIDE + (kc & 7) * 8) = v;
    }
    __syncthreads();
    f32x16 acc[MI][NI];
#pragma unroll
    for (int mi = 0; mi < MI; ++mi)
#pragma unroll
      for (int ni = 0; ni < NI; ++ni)
#pragma unroll
        for (int i = 0; i < 16; ++i) acc[mi][ni][i] = 0.f;
    gemm_compute<WM, WN, MI, NI>(smem, smem + ATILE, wm, wn, r, hf, acc);
    gemm_compute<WM, WN, MI, NI>(smem + STAGE, smem + STAGE + ATILE, wm, wn, r, hf, acc);
    __syncthreads();
    {
      bf16_t* st = wave_stage<64>(smem, w);
      bf16_t* gp = UZ + (size_t)(chunk * 128 + wm * 64) * DIN + g * 256 + wn * 64;
      stage_load<64, 64>(st, gp, DIN, lane);
#pragma unroll
      for (int ni = 0; ni < NI; ++ni) {
        const int ch = g * 256 + wn * 64 + ni * 32 + r;
        const float lg = ln_g[ch], lb = ln_b[ch];
#pragma unroll
        for (int mi = 0; mi < MI; ++mi)
#pragma unroll
          for (int i = 0; i < 16; ++i) {
            const int tp = wm * 64 + mi * 32 + crow(i, hf);
            const float sv = lg * (acc[mi][ni][i] - ext[384 + tp]) + lb * ext[256 + tp] + b_s[g * 128 + tp];
            bf16_t* pz = st + (mi * 32 + crow(i, hf)) * LDS_STRIDE + ni * 32 + r;
            *pz = f2bf(bf2f(*pz) * sv);
            if (i == 15) asm volatile("" ::: "memory");
          }
      }
      stage_flush<64, 64>(st, gp, DIN, lane);
    }
  }
}

DI_ void out_phase(const bf16_t* A, const bf16_t* WoutT, const float* hin, float* hout, bf16_t* smem) {
  TILE_IDS();
  constexpr int WM = 2, WN = 4, MT = 8, NQ = 4;
  const int wm = w / WN, wn = w % WN, r16 = lane & 15, quad = lane >> 4;
  for (int t = blockIdx.x; t < 64 * 4; t += gridDim.x) {
    const int mt_ = (t & 7) + 8 * (t >> 5), nt = (t >> 3) & 3;
    GemmArgs g{A + (size_t)mt_ * 256 * DIN, DIN, nullptr, 0, 1 << 30, WoutT + (size_t)nt * 256 * DIN, DIN, 32};
    f32x4 acc[MT][NQ];
    gemm_mainloop16<WM, WN, MT, NQ>(g, smem, acc);
#pragma unroll
    for (int mt = 0; mt < MT; ++mt)
#pragma unroll
      for (int nq = 0; nq < NQ; ++nq)
#pragma unroll
        for (int j = 0; j < 4; ++j) {
          const size_t idx = (size_t)(mt_ * 256 + wm * 128 + mt * 16 + quad * 4 + j) * DM + nt * 256 + wn * 64 + nq * 16 + r16;
          hout[idx] = hin[idx] + acc[mt][nq][j];
        }
  }
}

DI_ void ssm_pre_phase(const Params& p, float* sm, bf16_t* WgT, bf16_t* YgT, float* lamL) {
  int tid_ = threadIdx.x; asm volatile("" : "+v"(tid_)); const int tid = tid_;
  const float *a_re = p.in[11], *a_im = p.in[12], *log_step = p.in[13], *b_re = p.in[14], *b_im = p.in[15];
  const float *c_re = p.in[16], *c_im = p.in[17], *d_skip = p.in[18];
  float* lp_re = sm;
  float* lp_im = sm + 17 * 64;
  float* bb_re = sm + 34 * 64;
  float* bb_im = bb_re + 1024;
  float* cc_re = bb_im + 1024;
  float* cc_im = cc_re + 1024;
  float* cf = cc_im + 1024;
  float* Kt = cf + 128;
  for (int item = blockIdx.x; item < 256; item += gridDim.x) {
    const int g = item >> 1, half = item & 1;
    __syncthreads();
    if (tid < 64) {
      const float st = expf(log_step[g]);
      const float ar = a_re[g * 64 + tid], ai = a_im[g * 64 + tid];
      const float zr = ar * st, zi = ai * st;
      for (int tau = 0; tau <= 16; ++tau) {
        float e = expf(zr * (float)tau), sn, cs;
        sincos_red(zi * (float)tau, &sn, &cs);
        lp_re[tau * 64 + tid] = e * cs; lp_im[tau * 64 + tid] = e * sn;
      }
      float sn, cs; sincos_red(zi, &sn, &cs);
      float sh, ch; sincos_red(0.5f * zi, &sh, &ch);
      const float em1 = expm1f(zr);
      const float nr = em1 * cs - 2.f * sh * sh, ni = (em1 + 1.f) * sn;
      const float den = 1.f / (ar * ar + ai * ai);
      cf[tid] = (nr * ar + ni * ai) * den; cf[64 + tid] = (ni * ar - nr * ai) * den;
    }
    __syncthreads();
    for (int e = tid; e < 1024; e += NT) {
      const int pp = e >> 4;
      const float br = b_re[(size_t)g * 1024 + e], bi = b_im[(size_t)g * 1024 + e];
      const float cr = cf[pp], ci = cf[64 + pp];
      bb_re[e] = cr * br - ci * bi; bb_im[e] = cr * bi + ci * br;
      cc_re[e] = c_re[(size_t)g * 1024 + e]; cc_im[e] = c_im[(size_t)g * 1024 + e];
    }
    __syncthreads();
    for (int e = tid; e < 4096; e += NT) {
      const int tau = e >> 8, ho = (e >> 4) & 15, hi = e & 15;
      float acc = 0.f;
      for (int pp = 0; pp < 64; ++pp) {
        const float cr = cc_re[ho * 64 + pp], ci = cc_im[ho * 64 + pp];
        const float lr = lp_re[tau * 64 + pp], li = lp_im[tau * 64 + pp];
        const float dr = cr * lr - ci * li, di = cr * li + ci * lr;
        acc += dr * bb_re[pp * 16 + hi] - di * bb_im[pp * 16 + hi];
      }
      if (tau == 0 && ho == hi) acc += d_skip[g * 16 + ho];
      Kt[e] = acc;
    }
    __syncthreads();
    for (int e = half * 32768 + tid; e < (half + 1) * 32768; e += NT) {
      const int n = e >> 8, k = e & 255, t = n >> 4, ho = n & 15, sx = k >> 4, hi = k & 15;
      const float v = (sx <= t) ? Kt[((t - sx) * 16 + ho) * 16 + hi] : 0.f;
      YgT[((size_t)g * 256 + n) * 384 + k] = f2bf(v);
    }
    for (int e = half * 8192 + tid; e < (half + 1) * 8192; e += NT) {
      const int n = e >> 6, pp = e & 63, t = n >> 4, ho = n & 15;
      const float cr = cc_re[ho * 64 + pp], ci = cc_im[ho * 64 + pp];
      const float lr = lp_re[(t + 1) * 64 + pp], li = lp_im[(t + 1) * 64 + pp];
      YgT[((size_t)g * 256 + n) * 384 + 256 + pp] = f2bf(cr * lr - ci * li);
      YgT[((size_t)g * 256 + n) * 384 + 320 + pp] = f2bf(-(cr * li + ci * lr));
    }
    for (int e = half * 8192 + tid; e < (half + 1) * 8192; e += NT) {
      const int pp = e >> 8, k = e & 255, j = k >> 4, hh = k & 15;
      const float lr = lp_re[(15 - j) * 64 + pp], li = lp_im[(15 - j) * 64 + pp];
      const float br = bb_re[pp * 16 + hh], bi = bb_im[pp * 16 + hh];
      WgT[((size_t)g * 128 + pp) * 256 + k] = f2bf(lr * br - li * bi);
      WgT[((size_t)g * 128 + 64 + pp) * 256 + k] = f2bf(lr * bi + li * br);
    }
    if (tid < 64) { lamL[g * 128 + tid] = lp_re[16 * 64 + tid]; lamL[g * 128 + 64 + tid] = lp_im[16 * 64 + tid]; }
  }
}

DI_ void s5_inu_phase(const bf16_t* HB, const bf16_t* WinT, bf16_t* Uc, bf16_t* smem) {
  TILE_IDS(); CFG_A16();
  for (int t = blockIdx.x; t < 64 * 8; t += gridDim.x) {
    const int mt_ = (t & 7) + 8 * (t >> 6), nt = (t >> 3) & 7;
    GemmArgs g{HB + (size_t)mt_ * 256 * DM, DM, nullptr, 0, 1 << 30, WinT + (size_t)nt * 256 * DM, DM, 16};
    f32x4 acc[MT][NQ];
    gemm_mainloop16<WM, WN, MT, NQ>(g, smem, acc);
    {
      bf16_t* st = smem + w * (128 * LDS_STRIDE);
#pragma unroll
      for (int mt = 0; mt < MT; ++mt)
#pragma unroll
        for (int nq = 0; nq < NQ; ++nq)
#pragma unroll
          for (int j = 0; j < 4; ++j) {
            const int rl = mt * 16 + quad * 4 + j, cl = nq * 16 + r16;
            st[((cl >> 4) * 8 + (rl >> 4)) * 256 + (rl & 15) * 16 + (cl & 15)] = f2bf(acc[mt][nq][j]);
          }
      stage_sync();
      const int g0 = (nt * 256 + wn * 64) >> 4, n0 = (mt_ * 256 + wm * 128) >> 4;
#pragma unroll 4
      for (int it = 0; it < 16; ++it) {
        const int blk = it * 2 + (lane >> 5), gl = blk >> 3, nl = blk & 7;
        const uint4 v = *(const uint4*)(st + blk * 256 + (lane & 31) * 8);
        *(uint4*)(Uc + ((size_t)(g0 + gl) * 1024 + n0 + nl) * 256 + (lane & 31) * 8) = v;
      }
      stage_sync();
    }
  }
}
DI_ void s5_inz_phase(const bf16_t* HB, const bf16_t* WinTz, bf16_t* Z, bf16_t* smem) {
  TILE_IDS(); CFG_A16();
  for (int t = blockIdx.x; t < 64 * 8; t += gridDim.x) {
    const int mt_ = (t & 7) + 8 * (t >> 6), nt = (t >> 3) & 7;
    GemmArgs g{HB + (size_t)mt_ * 256 * DM, DM, nullptr, 0, 1 << 30, WinTz + (size_t)nt * 256 * DM, DM, 16};
    f32x4 acc[MT][NQ];
    gemm_mainloop16<WM, WN, MT, NQ>(g, smem, acc);
    bf16_t* st = wave_stage<128>(smem, w);
#pragma unroll
    for (int mt = 0; mt < MT; ++mt)
#pragma unroll
      for (int nq = 0; nq < NQ; ++nq)
#pragma unroll
        for (int j = 0; j < 4; ++j)
          st[(mt * 16 + quad * 4 + j) * LDS_STRIDE + nq * 16 + r16] = f2bf(siluf_(acc[mt][nq][j]));
    stage_flush<128, 64>(st, Z + (size_t)(mt_ * 256 + wm * 128) * DIN + nt * 256 + wn * 64, DIN, lane);
  }
}
DI_ void s5_sgemm_phase(const bf16_t* Uc, const bf16_t* WgT, const float* lamL, bf16_t* Sx, bf16_t* smem) {
  TILE_IDS(); CFG_B16();
  float* Sl = (float*)smem;
  float* xch = Sl + 256 * 129;
  for (int t = blockIdx.x; t < 128 * 4; t += gridDim.x) {
    const int gi = t >> 2, mt_ = t & 3;
    GemmArgs g{Uc + ((size_t)gi * 1024 + mt_ * 256) * 256, 256, nullptr, 0, 1 << 30, WgT + (size_t)gi * 128 * 256, 256, 4};
    f32x4 acc[MT][NQ];
    gemm_mainloop16<WM, WN, MT, NQ>(g, smem, acc);
#pragma unroll
    for (int mt = 0; mt < MT; ++mt)
#pragma unroll
      for (int nq = 0; nq < NQ; ++nq)
#pragma unroll
        for (int j = 0; j < 4; ++j)
          Sl[(wm * 64 + mt * 16 + quad * 4 + j) * 129 + wn * 64 + nq * 16 + r16] = acc[mt][nq][j];
    __syncthreads();
    {
      const int pp = tid & 63, seg = tid >> 6;
      const float lr = lamL[gi * 128 + pp], li = lamL[gi * 128 + 64 + pp];
      const float* sp = Sl + (seg * 32) * 129 + pp;
      float xr = 0.f, xi = 0.f;
#pragma unroll 8
      for (int c = 0; c < 32; ++c) { const float sr = sp[c * 129], si = sp[c * 129 + 64]; const float tt = lr * xr - li * xi + sr; xi = lr * xi + li * xr + si; xr = tt; }
      xch[seg * 128 + pp] = xr; xch[seg * 128 + 64 + pp] = xi;
      __syncthreads();
      float ar = lr, ai = li;
#pragma unroll
      for (int q = 0; q < 5; ++q) { const float tt = ar * ar - ai * ai; ai = 2.f * ar * ai; ar = tt; }
      xr = 0.f; xi = 0.f;
      for (int s2 = 0; s2 < seg; ++s2) { const float tt = ar * xr - ai * xi + xch[s2 * 128 + pp]; xi = ar * xi + ai * xr + xch[s2 * 128 + 64 + pp]; xr = tt; }
      bf16_t* base = Sx + ((size_t)(mt_ * 256 + seg * 32) * 128 + gi) * 128 + pp;
#pragma unroll 8
      for (int c = 0; c < 32; ++c) {
        base[(size_t)c * 16384] = f2bf(xr); base[(size_t)c * 16384 + 64] = f2bf(xi);
        const float sr = sp[c * 129], si = sp[c * 129 + 64];
        const float tt = lr * xr - li * xi + sr; xi = lr * xi + li * xr + si; xr = tt;
      }
    }
  }
}
DI_ void s5_scan_phase(bf16_t* Sx, const float* lamL, float* sm) {
  int tid_ = threadIdx.x; asm volatile("" : "+v"(tid_)); const int tid = tid_;
  const int pp = tid & 63, seg = tid >> 6;
  for (int item = blockIdx.x; item < 512; item += gridDim.x) {
    const int b = item >> 7, g = item & 127;
    const float lr = lamL[g * 128 + pp], li = lamL[g * 128 + 64 + pp];
    bf16_t* base = Sx + ((size_t)(b * 256 + seg * 32) * 128 + g) * 128 + pp;
    float xr = 0.f, xi = 0.f;
    for (int c0 = 0; c0 < 32; c0 += 8) {
      float sr[8], si[8];
#pragma unroll
      for (int c = 0; c < 8; ++c) { sr[c] = bf2f(base[(size_t)(c0 + c) * 16384]); si[c] = bf2f(base[(size_t)(c0 + c) * 16384 + 64]); }
#pragma unroll
      for (int c = 0; c < 8; ++c) { const float t = lr * xr - li * xi + sr[c]; xi = lr * xi + li * xr + si[c]; xr = t; }
    }
    __syncthreads();
    sm[seg * 128 + pp] = xr; sm[seg * 128 + 64 + pp] = xi;
    __syncthreads();
    float ar = lr, ai = li;
#pragma unroll
    for (int q = 0; q < 5; ++q) { const float t = ar * ar - ai * ai; ai = 2.f * ar * ai; ar = t; }
    xr = 0.f; xi = 0.f;
    for (int s2 = 0; s2 < seg; ++s2) { const float t = ar * xr - ai * xi + sm[s2 * 128 + pp]; xi = ar * xi + ai * xr + sm[s2 * 128 + 64 + pp]; xr = t; }
    for (int c0 = 0; c0 < 32; c0 += 8) {
      float sr[8], si[8];
#pragma unroll
      for (int c = 0; c < 8; ++c) { sr[c] = bf2f(base[(size_t)(c0 + c) * 16384]); si[c] = bf2f(base[(size_t)(c0 + c) * 16384 + 64]); }
#pragma unroll
      for (int c = 0; c < 8; ++c) {
        base[(size_t)(c0 + c) * 16384] = f2bf(xr); base[(size_t)(c0 + c) * 16384 + 64] = f2bf(xi);
        const float t = lr * xr - li * xi + sr[c]; xi = lr * xi + li * xr + si[c]; xr = t;
      }
    }
  }
}
DI_ void s5_ygemm_phase(const bf16_t* Uc, const bf16_t* Sx, const bf16_t* YgT, bf16_t* Y, bf16_t* smem) {
  TILE_IDS(); CFG_A16();
  for (int t = blockIdx.x; t < 128 * 4; t += gridDim.x) {
    const int xq = t & 7, kq = t >> 3;
    const int gi = xq * 16 + (kq >> 2), mt_ = kq & 3;
    GemmArgs g{Uc + ((size_t)gi * 1024 + mt_ * 256) * 256, 256, Sx + ((size_t)mt_ * 256 * 128 + gi) * 128, 16384, 4,
               YgT + (size_t)gi * 256 * 384, 384, 6};
    f32x4 acc[MT][NQ];
    gemm_mainloop16<WM, WN, MT, NQ>(g, smem, acc);
#pragma unroll
    for (int mt = 0; mt < MT; ++mt)
#pragma unroll
      for (int nq = 0; nq < NQ; ++nq)
#pragma unroll
        for (int j = 0; j < 4; ++j) {
          const int row = mt_ * 256 + wm * 128 + mt * 16 + quad * 4 + j;
          Y[((size_t)row * 16 + wn * 4 + nq) * DIN + gi * 16 + r16] = f2bf(geluf_(acc[mt][nq][j]));
        }
  }
}
DI_ void s5_glu_phase(const bf16_t* HB, const bf16_t* WinTz, const bf16_t* Y, const bf16_t* WgluT, const float* b_glu, bf16_t* Z, bf16_t* smem) {
  TILE_IDS(); CFG_A16();
  for (int t = blockIdx.x; t < 64 * 8; t += gridDim.x) {
    const int mt_ = (t & 7) + 8 * (t >> 6), nt = (t >> 3) & 7;
    f32x4 acc[MT][NQ];
    {
      GemmArgs gz{HB + (size_t)mt_ * 256 * DM, DM, nullptr, 0, 1 << 30, WinTz + (size_t)nt * 256 * DM, DM, 16};
      gemm_mainloop16<WM, WN, MT, NQ>(gz, smem, acc);
      bf16_t* stz = wave_stage<128>(smem, w);
#pragma unroll
      for (int mt = 0; mt < MT; ++mt)
#pragma unroll
        for (int nq = 0; nq < NQ; ++nq)
#pragma unroll
          for (int j = 0; j < 4; ++j)
            stz[(mt * 16 + quad * 4 + j) * LDS_STRIDE + nq * 16 + r16] = f2bf(siluf_(acc[mt][nq][j]));
      stage_flush<128, 64>(stz, Z + (size_t)(mt_ * 256 + wm * 128) * DIN + nt * 256 + wn * 64, DIN, lane);
    }
    GemmArgs g{Y + (size_t)mt_ * 256 * DIN, DIN, nullptr, 0, 1 << 30, WgluT + (size_t)nt * 256 * DIN, DIN, 32};
    gemm_mainloop16<WM, WN, MT, NQ>(g, smem, acc);
    {
      bf16_t* stY = smem + w * (128 * LDS_STRIDE);
      bf16_t* stZ = stY + 64 * LDS_STRIDE;
      const float* bgp = b_glu + nt * 256 + wn * 64 + r16;
      const float bg0 = bgp[0], bg1 = bgp[16], bg2 = bgp[32], bg3 = bgp[48];
#pragma unroll
      for (int h2 = 0; h2 < 2; ++h2) {
        const size_t off = (size_t)(mt_ * 256 + wm * 128 + h2 * 64) * DIN + nt * 256 + wn * 64;
        stage_load<64, 64>(stY, Y + off, DIN, lane);
        stage_load<64, 64>(stZ, Z + off, DIN, lane);
#pragma unroll
        for (int m2 = 0; m2 < 4; ++m2)
#pragma unroll
          for (int nq = 0; nq < NQ; ++nq)
#pragma unroll
            for (int j = 0; j < 4; ++j) {
              const int idx = (m2 * 16 + quad * 4 + j) * LDS_STRIDE + nq * 16 + r16;
              const float yv = bf2f(stY[idx]);
              stZ[idx] = f2bf(yv * sigmoidf_(acc[h2 * 4 + m2][nq][j] + (nq == 0 ? bg0 : nq == 1 ? bg1 : nq == 2 ? bg2 : bg3)) * bf2f(stZ[idx]));
            }
        stage_flush<64, 64>(stZ, Z + off, DIN, lane);
      }
    }
  }
}

DI_ void mla_wq_phase(const float* w_uq, const float* w_ukv, const float* gq, const float* gkv, bf16_t* WqT, float* sm) {
  int tid_ = threadIdx.x; asm volatile("" : "+v"(tid_)); const int tid = tid_;
  float* As = sm;
  float* Bs = sm + 32 * 129;
  float* Os = Bs + 128 * 129;
  for (int item = blockIdx.x; item < 16 * 12; item += gridDim.x) {
    const int h = item / 12, c0 = (item % 12) * 32;
    __syncthreads();
#pragma unroll
    for (int q = 0; q < 2; ++q) {
      const int e = tid + q * NT, ci = e >> 5, d4 = e & 31;
      const float4 v = *(const float4*)(w_uq + (size_t)(c0 + ci) * 3072 + h * 192 + d4 * 4);
      float* p_ = As + ci * 129 + d4 * 4; p_[0] = v.x; p_[1] = v.y; p_[2] = v.z; p_[3] = v.w;
    }
#pragma unroll
    for (int q = 0; q < 8; ++q) {
      const int e = tid + q * NT, rr = e >> 5, d4 = e & 31;
      const float4 v = *(const float4*)(w_ukv + (size_t)rr * 4096 + h * 256 + d4 * 4);
      float* p_ = Bs + rr * 129 + d4 * 4; p_[0] = v.x; p_[1] = v.y; p_[2] = v.z; p_[3] = v.w;
    }
    __syncthreads();
    {
      const int rr = tid & 127, cg = tid >> 7;
      float acc[8];
#pragma unroll
      for (int j = 0; j < 8; ++j) acc[j] = 0.f;
      for (int d = 0; d < 128; ++d) {
        const float bv = Bs[rr * 129 + d];
#pragma unroll
        for (int j = 0; j < 8; ++j) acc[j] += As[(cg + 4 * j) * 129 + d] * bv;
      }
      const float gk = gkv[rr];
#pragma unroll
      for (int j = 0; j < 8; ++j) Os[rr * 33 + cg + 4 * j] = acc[j] * gk * gq[c0 + cg + 4 * j];
    }
    __syncthreads();
#pragma unroll
    for (int q = 0; q < 8; ++q) {
      const int e = tid + q * NT, rr = e >> 5, ci = e & 31;
      WqT[(size_t)(h * 192 + rr) * 384 + c0 + ci] = f2bf(Os[rr * 33 + ci]);
    }
  }
  for (int idx = blockIdx.x * NT + tid; idx < 16 * 64 * 384; idx += gridDim.x * NT) {
    const int c = idx % 384, nn = idx / 384, h = nn >> 6, j = nn & 63, n = h * 192 + 128 + j;
    WqT[(size_t)n * 384 + c] = f2bf(w_uq[(size_t)c * 3072 + n] * gq[c]);
  }
}
DI_ void rope_table_phase(const int* pos, float* cosT, float* sinT) {
  for (int idx = blockIdx.x * NT + threadIdx.x; idx < T_TOK * 32; idx += gridDim.x * NT) {
    const float ang = (float)pos[idx >> 5] * INVF[idx & 31];
    float sn, cs; sincos_red(ang, &sn, &cs);
    cosT[idx] = cs; sinT[idx] = sn;
  }
}
DI_ void mla_in_phase(const bf16_t* HB, const bf16_t* WinT, bf16_t* cq, float* qssq, float* ckv, bf16_t* Kc, bf16_t* Z,
                      const float* cosT, const float* sinT, bf16_t* smem) {
  TILE_IDS(); CFG_A16();
  for (int t = blockIdx.x; t < 64 * 11; t += gridDim.x) {
    const int mt_ = (t & 7) + 8 * (t / 88), nt = (t >> 3) % 11;
    GemmArgs g{HB + (size_t)mt_ * 256 * DM, DM, nullptr, 0, 1 << 30, WinT + (size_t)nt * 256 * DM, DM, 16};
    f32x4 acc[MT][NQ];
    gemm_mainloop16<WM, WN, MT, NQ>(g, smem, acc);
    const int rbase = mt_ * 256 + wm * 128;
    const int cb = nt * 4 + wn;
    bf16_t* st = wave_stage<128>(smem, w);
    if (cb < 6) {
#pragma unroll
      for (int mt = 0; mt < MT; ++mt)
#pragma unroll
        for (int nq = 0; nq < NQ; ++nq)
#pragma unroll
          for (int j = 0; j < 4; ++j)
            st[(mt * 16 + quad * 4 + j) * LDS_STRIDE + nq * 16 + r16] = f2bf(acc[mt][nq][j]);
      stage_rowstats<128>(st, lane, [&](int row, float s1, float s2) { (void)s1; qssq[(size_t)(rbase + row) * 8 + cb] = s2; });
      stage_flush<128, 64>(st, cq + (size_t)rbase * 384 + cb * 64, 384, lane);
    } else if (cb < 8) {
#pragma unroll
      for (int mt = 0; mt < MT; ++mt)
#pragma unroll
        for (int nq = 0; nq < NQ; ++nq)
#pragma unroll
          for (int j = 0; j < 4; ++j)
            ckv[(size_t)(rbase + mt * 16 + quad * 4 + j) * 128 + (cb - 6) * 64 + nq * 16 + r16] = acc[mt][nq][j];
    } else if (cb == 8) {
#pragma unroll
      for (int mt = 0; mt < MT; ++mt) {
#pragma unroll
        for (int nq = 0; nq < 2; ++nq)
#pragma unroll
          for (int j = 0; j < 4; ++j) {
            const int row = rbase + mt * 16 + quad * 4 + j, jj = nq * 16 + r16;
            const float cs = cosT[(size_t)row * 32 + jj], sn = sinT[(size_t)row * 32 + jj];
            const float x1 = acc[mt][nq][j], x2 = acc[mt][nq + 2][j];
            Kc[(size_t)row * 192 + 128 + jj] = f2bf(x1 * cs - x2 * sn);
            Kc[(size_t)row * 192 + 160 + jj] = f2bf(x2 * cs + x1 * sn);
          }
        asm volatile("" ::: "memory");
      }
    } else if (cb >= 10 && cb < 42) {
#pragma unroll
      for (int mt = 0; mt < MT; ++mt)
#pragma unroll
        for (int nq = 0; nq < NQ; ++nq)
#pragma unroll
          for (int j = 0; j < 4; ++j)
            st[(mt * 16 + quad * 4 + j) * LDS_STRIDE + nq * 16 + r16] = f2bf(siluf_(acc[mt][nq][j]));
      stage_flush<128, 64>(st, Z + (size_t)rbase * DIN + (cb - 10) * 64, DIN, lane);
    }
  }
}
DI_ void mla_q_phase(const bf16_t* cq, const float* qssq, const bf16_t* WqT, bf16_t* Qp, const float* cosT, const float* sinT,
                     const float* ckv, bf16_t* Kc, bf16_t* KcT, bf16_t* smem) {
  TILE_IDS(); CFG_A16();
  const float QSC = 0.07216878364870322f * 1.4426950408889634f;
  float* fsc = (float*)((unsigned char*)smem + SMEM_MAIN);
  for (int t = blockIdx.x; t < 64 * 12; t += gridDim.x) {
    const int mt_ = (t & 7) + 8 * (t / 96), nt = (t >> 3) % 12;
    GemmArgs g{cq + (size_t)mt_ * 256 * 384, 384, nullptr, 0, 1 << 30, WqT + (size_t)nt * 256 * 384, 384, 6};
    f32x4 acc[MT][NQ];
    __syncthreads();
    if (tid < 256) {
      const float* ps = qssq + (size_t)(mt_ * 256 + tid) * 8;
      const float ss = ps[0] + ps[1] + ps[2] + ps[3] + ps[4] + ps[5];
      fsc[tid] = rsqrtf(ss * (1.f / 384.f) + 1e-6f) * QSC;
    }
    gemm_mainloop16s<WM, WN, MT, NQ>(g, smem, acc);
    const int cb = nt * 4 + wn;
    const bool is_rope = (cb % 3) == 2;
    const int colb = cb * 64;
    bf16_t* st = wave_stage<128>(smem, w);
#pragma unroll
    for (int mt = 0; mt < MT; ++mt) {
#pragma unroll
      for (int nq = 0; nq < 2; ++nq)
#pragma unroll
        for (int j = 0; j < 4; ++j) {
          const int rl = mt * 16 + quad * 4 + j, jj = nq * 16 + r16;
          const float f = fsc[wm * 128 + rl];
          float x1 = acc[mt][nq][j] * f, x2 = acc[mt][nq + 2][j] * f;
          if (is_rope) {
            const int row = mt_ * 256 + wm * 128 + rl;
            const float cs = cosT[(size_t)row * 32 + jj], sn = sinT[(size_t)row * 32 + jj];
            const float y1 = x1 * cs - x2 * sn, y2 = x2 * cs + x1 * sn;
            x1 = y1; x2 = y2;
          }
          st[rl * LDS_STRIDE + jj] = f2bf(x1);
          st[rl * LDS_STRIDE + 32 + jj] = f2bf(x2);
        }
      asm volatile("" ::: "memory");
      __builtin_amdgcn_sched_barrier(0);
    }
    stage_flush<128, 64>(st, Qp + (size_t)(mt_ * 256 + wm * 128) * 3072 + colb, 3072, lane);
  }
  float* tl = (float*)smem;
  float* rs = tl + 64 * 129;
  for (int item = blockIdx.x; item < T_TOK / 64; item += gridDim.x) {
    const int t0 = item * 64;
    __syncthreads();
    for (int e = tid; e < 64 * 128; e += NT) tl[(e >> 7) * 129 + (e & 127)] = ckv[(size_t)t0 * 128 + e];
    __syncthreads();
    {
      const int tok = tid >> 3, part = tid & 7;
      float ss = 0.f;
      for (int j = 0; j < 16; ++j) { const float v = tl[tok * 129 + part * 16 + j]; ss += v * v; }
      ss += __shfl_xor(ss, 1); ss += __shfl_xor(ss, 2); ss += __shfl_xor(ss, 4);
      if (part == 0) rs[tok] = rsqrtf(ss * (1.f / 128.f) + 1e-6f);
    }
    __syncthreads();
    for (int e = tid; e < 64 * 128; e += NT) {
      const int tok = e >> 7, rr = e & 127;
      Kc[(size_t)(t0 + tok) * 192 + rr] = f2bf(tl[tok * 129 + rr] * rs[tok]);
    }
    const int b = t0 >> 12, l0 = t0 & 4095;
    for (int e = tid; e < 64 * 128; e += NT) {
      const int rr = e >> 6, tok = e & 63;
      KcT[((size_t)b * 128 + rr) * SEQ + l0 + tok] = f2bf(tl[tok * 129 + rr] * rs[tok]);
    }
  }
}

constexpr int KT = 64;
constexpr int NSUB = KT / 32;
constexpr int KS_STRIDE = 200;
constexpr int VS_STRIDE = KT + 4;
DI_ void mla_attn_phase(const bf16_t* Qp, const bf16_t* Kc, const bf16_t* KcT, const bf16_t* WuvT, bf16_t* Z, bf16_t* smem) {
  TILE_IDS();
  bf16_t* Ks = smem;
  bf16_t* Vs = smem + KT * KS_STRIDE;
  bf16_t* Ws = smem + 36864;
  const int G = gridDim.x;
  for (int round = 0;; ++round) {
    const int slot = (round & 1) ? (G - 1 - (int)blockIdx.x) : (int)blockIdx.x;
    const int item = round * G + slot;
    if (item >= 1024) break;
    const int qb = 15 - (item >> 6), bh = item & 63, b = bh >> 4, h = bh & 15;
    const int q0 = qb * 256, qw0 = q0 + w * 32, qrow = qw0 + r;
    const size_t tok = (size_t)b * SEQ + qrow;
    bf16x8 qf[12];
    {
      const bf16_t* qptr = Qp + tok * 3072 + h * 192 + hf * 8;
#pragma unroll
      for (int ks = 0; ks < 12; ++ks) qf[ks] = *(const bf16x8*)(qptr + ks * 16);
    }
    {
      const bf16_t* wsrc = WuvT + (size_t)h * 128 * 128;
#pragma unroll
      for (int i = 0; i < 4; ++i) {
        const int row = i * 32 + (tid >> 4), slot = tid & 15;
        __builtin_amdgcn_global_load_lds((const unsigned*)(wsrc + row * 128 + ((slot ^ (row & 15)) * 8)), (unsigned*)(Ws + (i * NT + tid) * 8), 16, 0, 0);
      }
    }
    f32x16 O[4];
#pragma unroll
    for (int dt = 0; dt < 4; ++dt)
#pragma unroll
      for (int i = 0; i < 16; ++i) O[dt][i] = 0.f;
    float m = -1e30f, ls = 0.f;
    const int ntile = (q0 + 256) / KT;
    const bf16_t* Kg = Kc + (size_t)b * SEQ * 192;
    const bf16_t* Vg = KcT + (size_t)b * 128 * SEQ;
    const int kc0 = tid, kc1 = tid + 512, kc2 = tid + 1024;
    const int kr0 = kc0 / 24, kr1 = kc1 / 24, kr2 = kc2 / 24;
    const int ko0 = kr0 * 192 + (kc0 - kr0 * 24) * 8, ko1 = kr1 * 192 + (kc1 - kr1 * 24) * 8, ko2 = kr2 * 192 + (kc2 - kr2 * 24) * 8;
    const int kl0 = kr0 * KS_STRIDE + (kc0 - kr0 * 24) * 8, kl1 = kr1 * KS_STRIDE + (kc1 - kr1 * 24) * 8, kl2 = kr2 * KS_STRIDE + (kc2 - kr2 * 24) * 8;
    const int vr0 = tid >> 3, vr1 = (tid + 512) >> 3, vcc = (tid & 7) * 8;
    uint4 rk0 = *(const uint4*)(Kg + ko0), rk1 = *(const uint4*)(Kg + ko1), rk2 = *(const uint4*)(Kg + ko2);
    uint4 rv0 = *(const uint4*)(Vg + (size_t)vr0 * SEQ + vcc), rv1 = *(const uint4*)(Vg + (size_t)vr1 * SEQ + vcc);
    for (int kt = 0; kt < ntile; ++kt) {
      __syncthreads();
      *(uint4*)(Ks + kl0) = rk0; *(uint4*)(Ks + kl1) = rk1; *(uint4*)(Ks + kl2) = rk2;
      { uint2 lo, hi; lo.x = rv0.x; lo.y = rv0.y; hi.x = rv0.z; hi.y = rv0.w;
        *(uint2*)(Vs + vr0 * VS_STRIDE + vcc) = lo; *(uint2*)(Vs + vr0 * VS_STRIDE + vcc + 4) = hi; }
      { uint2 lo, hi; lo.x = rv1.x; lo.y = rv1.y; hi.x = rv1.z; hi.y = rv1.w;
        *(uint2*)(Vs + vr1 * VS_STRIDE + vcc) = lo; *(uint2*)(Vs + vr1 * VS_STRIDE + vcc + 4) = hi; }
      __syncthreads();
      if (kt + 1 < ntile) {
        const int k1 = (kt + 1) * KT;
        const bf16_t* Kn = Kg + (size_t)k1 * 192;
        rk0 = *(const uint4*)(Kn + ko0); rk1 = *(const uint4*)(Kn + ko1); rk2 = *(const uint4*)(Kn + ko2);
        rv0 = *(const uint4*)(Vg + (size_t)vr0 * SEQ + k1 + vcc); rv1 = *(const uint4*)(Vg + (size_t)vr1 * SEQ + k1 + vcc);
      }
      const int k0 = kt * KT;
      if (k0 <= qw0 + 31) {
        f32x16 st[NSUB];
#pragma unroll
        for (int sub = 0; sub < NSUB; ++sub) {
#pragma unroll
          for (int i = 0; i < 16; ++i) st[sub][i] = 0.f;
#pragma unroll
          for (int ks = 0; ks < 12; ++ks) {
            bf16x8 a = *(const bf16x8*)(Ks + (sub * 32 + r) * KS_STRIDE + ks * 16 + hf * 8);
            st[sub] = MFMA32(a, qf[ks], st[sub]);
            if ((ks & 3) == 3) __builtin_amdgcn_sched_barrier(0);
          }
        }
        if (k0 + KT - 1 > qw0) {
#pragma unroll
          for (int sub = 0; sub < NSUB; ++sub)
#pragma unroll
            for (int i = 0; i < 16; ++i)
              if (k0 + sub * 32 + crow(i, hf) > qrow) st[sub][i] = -1e30f;
        }
        float mx = -1e30f;
#pragma unroll
        for (int sub = 0; sub < NSUB; ++sub)
#pragma unroll
          for (int i = 0; i < 16; ++i) mx = fmaxf(mx, st[sub][i]);
        mx = fmaxf(mx, __shfl_xor(mx, 32));
        if (!__all(mx - m <= 8.f)) {
          const float mn = fmaxf(m, mx);
          const float alpha = __builtin_amdgcn_exp2f(m - mn);
          m = mn;
          ls *= alpha;
#pragma unroll
          for (int dt = 0; dt < 4; ++dt)
#pragma unroll
            for (int i = 0; i < 16; ++i) O[dt][i] *= alpha;
        }
        float psum = 0.f;
#pragma unroll
        for (int sub = 0; sub < NSUB; ++sub)
#pragma unroll
          for (int i = 0; i < 16; ++i) { const float pv = __builtin_amdgcn_exp2f(st[sub][i] - m); st[sub][i] = pv; psum += pv; }
        ls += psum;
#pragma unroll
        for (int sub = 0; sub < NSUB; ++sub)
#pragma unroll
          for (int s2 = 0; s2 < 2; ++s2) {
            u32x4 pfu;
#pragma unroll
            for (int j = 0; j < 4; ++j) pfu[j] = pack2(st[sub][8 * s2 + 2 * j], st[sub][8 * s2 + 2 * j + 1]);
            const bf16x8 pf = __builtin_bit_cast(bf16x8, pfu);
#pragma unroll
            for (int dt = 0; dt < 4; ++dt) {
              const bf16_t* vp = Vs + (dt * 32 + r) * VS_STRIDE + sub * 32 + s2 * 16 + hf * 4;
              const uint2 vlo = *(const uint2*)vp;
              const uint2 vhi = *(const uint2*)(vp + 8);
              u32x4 vau; vau[0] = vlo.x; vau[1] = vlo.y; vau[2] = vhi.x; vau[3] = vhi.y;
              O[dt] = MFMA32(__builtin_bit_cast(bf16x8, vau), pf, O[dt]);
            }
          }
      }
    }
    const float lt = ls + __shfl_xor(ls, 32);
    const float inv = 1.f / lt;
    f32x16 U[4];
#pragma unroll
    for (int dq = 0; dq < 4; ++dq)
#pragma unroll
      for (int i = 0; i < 16; ++i) U[dq][i] = 0.f;
#pragma unroll
    for (int dt = 0; dt < 4; ++dt)
#pragma unroll
      for (int s2 = 0; s2 < 2; ++s2) {
        u32x4 ofu;
#pragma unroll
        for (int j = 0; j < 4; ++j) ofu[j] = pack2(O[dt][8 * s2 + 2 * j] * inv, O[dt][8 * s2 + 2 * j + 1] * inv);
        const bf16x8 of = __builtin_bit_cast(bf16x8, ofu);
        const int dv0 = dt * 32 + s2 * 16 + hf * 4;
        const int c0 = dv0 >> 3, hb = (dv0 & 7);
#pragma unroll
        for (int dq = 0; dq < 4; ++dq) {
          const int R = dq * 32 + r;
          const uint2 wlo = *(const uint2*)(Ws + R * 128 + ((c0 ^ (R & 15)) * 8) + hb);
          const uint2 whi = *(const uint2*)(Ws + R * 128 + (((c0 + 1) ^ (R & 15)) * 8) + hb);
          u32x4 wau; wau[0] = wlo.x; wau[1] = wlo.y; wau[2] = whi.x; wau[3] = whi.y;
          U[dq] = MFMA32(__builtin_bit_cast(bf16x8, wau), of, U[dq]);
        }
      }
    __syncthreads();
    {
      bf16_t* so = smem + w * (32 * 136);
#pragma unroll
      for (int dq = 0; dq < 4; ++dq)
#pragma unroll
        for (int i4 = 0; i4 < 4; ++i4) {
          uint2 o;
          o.x = pack2(U[dq][i4 * 4 + 0], U[dq][i4 * 4 + 1]);
          o.y = pack2(U[dq][i4 * 4 + 2], U[dq][i4 * 4 + 3]);
          *(uint2*)(so + r * 136 + dq * 32 + i4 * 8 + hf * 4) = o;
        }
      stage_sync();
      bf16_t* zb = Z + ((size_t)b * SEQ + qw0) * DIN + h * 128;
#pragma unroll 4
      for (int it = 0; it < 8; ++it) {
        const int row = it * 4 + (lane >> 4), ch = lane & 15;
        const uint4 uv = *(const uint4*)(so + row * 136 + ch * 8);
        bf16_t* pz = zb + (size_t)row * DIN + ch * 8;
        const uint4 zv = *(const uint4*)pz;
        const unsigned uu[4] = {uv.x, uv.y, uv.z, uv.w}, zz[4] = {zv.x, zv.y, zv.z, zv.w};
        unsigned oo[4];
#pragma unroll
        for (int j = 0; j < 4; ++j)
          oo[j] = pack2(__uint_as_float(uu[j] << 16) * __uint_as_float(zz[j] << 16), __uint_as_float(uu[j] & 0xffff0000u) * __uint_as_float(zz[j] & 0xffff0000u));
        uint4 ov; ov.x = oo[0]; ov.y = oo[1]; ov.z = oo[2]; ov.w = oo[3];
        *(uint4*)pz = ov;
      }
    }
    __syncthreads();
  }
}
DI_ void mla_uv_phase(const bf16_t* Qp, const bf16_t* WuvT, bf16_t* Z, bf16_t* smem) {
  TILE_IDS(); CFG_B();
  for (int t = blockIdx.x; t < 64 * 16; t += gridDim.x) {
    const int mt = t >> 4, h = t & 15;
    GemmArgs g{Qp + (size_t)mt * 256 * 3072 + h * 192, 3072, nullptr, 0, 1 << 30, WuvT + (size_t)h * 128 * 128, 128, 2};
    f32x16 acc[MI][NI];
    gemm_mainloop<WM, WN, MI, NI>(g, smem, acc);
    {
      bf16_t* st = wave_stage<64>(smem, w);
      bf16_t* gp = Z + (size_t)(mt * 256 + wm * 64) * DIN + h * 128 + wn * 64;
      stage_load<64, 64>(st, gp, DIN, lane);
#pragma unroll
      for (int mi = 0; mi < MI; ++mi)
#pragma unroll
        for (int ni = 0; ni < NI; ++ni)
#pragma unroll
          for (int i = 0; i < 16; ++i) {
            bf16_t* pz = st + (mi * 32 + crow(i, hf)) * LDS_STRIDE + ni * 32 + r;
            *pz = f2bf(acc[mi][ni][i] * bf2f(*pz));
          }
      stage_flush<64, 64>(st, gp, DIN, lane);
    }
  }
}

#define XB_TMO      128
#define XB_XCNT(j)  (256  + 64 * (j))
#define XB_XSUB(j)  (1280 + 64 * (j))
#define XB_XGEN(j)  (2304 + 64 * (j))
#define XB_TOP      3328
#define XB_TOPGEN   3392
#define XCD_BAR_WORDS 3456
#define XB_SPIN_CAP (1u << 18)
#define LAS __attribute__((address_space(3)))
DI_ unsigned xb_ld(unsigned* p)              { return __hip_atomic_load(p, __ATOMIC_RELAXED, __HIP_MEMORY_SCOPE_AGENT); }
DI_ unsigned xb_add(unsigned* p, unsigned v) { return __hip_atomic_fetch_add(p, v, __ATOMIC_RELAXED, __HIP_MEMORY_SCOPE_AGENT); }
DI_ unsigned xb_xcc_id() { return (unsigned)__builtin_amdgcn_s_getreg((3 << 11) | 20) & 0xFu; }
#define XB_SPIN(cond, bar) do { unsigned _sp = 0; while (cond) { __builtin_amdgcn_s_sleep(1); \
    if ((++_sp & 255u) == 0u) { if (xb_ld(&(bar)[XB_TMO])) break; if (_sp > XB_SPIN_CAP) { atomicAdd(&(bar)[XB_TMO], 1u); break; } } } } while (0)
struct XcdBarrier { unsigned* bar; unsigned x; volatile LAS unsigned* st; };
DI_ XcdBarrier xcd_barrier_post(unsigned* bar, volatile LAS unsigned* st) {
  XcdBarrier b; b.bar = bar; b.x = xb_xcc_id(); b.st = st;
  if (threadIdx.x == 0) (void)xb_add(&bar[XB_XCNT(b.x)], 1u);
  return b;
}
DI_ void xcd_barrier_complete(unsigned* bar, unsigned x, unsigned& nloc, unsigned& nx) {
  const unsigned G = gridDim.x * gridDim.y * gridDim.z;
  unsigned sum, cnt, mine, sp = 0u;
  for (;;) {
    sum = 0u; cnt = 0u; mine = 0u;
#pragma unroll
    for (unsigned j = 0; j < 16; ++j) { const unsigned c = xb_ld(&bar[XB_XCNT(j)]); sum += c; cnt += (c > 0u) ? 1u : 0u; mine = (j == x) ? c : mine; }
    if (sum == G) break;
    __builtin_amdgcn_s_sleep(1);
    if ((++sp & 255u) == 0u) { if (xb_ld(&bar[XB_TMO])) break; if (sp > XB_SPIN_CAP) { atomicAdd(&bar[XB_TMO], 1u); break; } }
  }
  nloc = mine > 0u ? mine : 1u; nx = cnt > 0u ? cnt : 1u;
}
DI_ void xcd_barrier(const XcdBarrier& b) {
  asm volatile("s_waitcnt vmcnt(0)" ::: "memory");
  __syncthreads();
  if (threadIdx.x == 0) {
    unsigned* bar = b.bar;
    __builtin_amdgcn_s_waitcnt(0);
    unsigned nloc = b.st[0], nx = b.st[1];
    if (nloc == 0u) { xcd_barrier_complete(bar, b.x, nloc, nx); b.st[0] = nloc; b.st[1] = nx; }
    const unsigned old = xb_add(&bar[XB_XSUB(b.x)], 1u);
    const unsigned gen = old / nloc;
    if (old + 1u == (gen + 1u) * nloc) {
      __builtin_amdgcn_fence(__ATOMIC_RELEASE, "agent");
      asm volatile("s_waitcnt vmcnt(0)" ::: "memory");
      const unsigned og = xb_add(&bar[XB_TOP], 1u);
      const unsigned tg = og / nx;
      if (og + 1u == (tg + 1u) * nx) xb_add(&bar[XB_TOPGEN], 1u);
      else XB_SPIN(xb_ld(&bar[XB_TOPGEN]) == tg, bar);
      __builtin_amdgcn_fence(__ATOMIC_ACQUIRE, "agent");
      xb_add(&bar[XB_XGEN(b.x)], 1u);
      asm volatile("s_waitcnt vmcnt(0)" ::: "memory");
    } else {
      XB_SPIN(xb_ld(&bar[XB_XGEN(b.x)]) == gen, bar);
      __builtin_amdgcn_fence(__ATOMIC_ACQUIRE, "agent");
      asm volatile("s_waitcnt vmcnt(0)" ::: "memory");
    }
  }
  __syncthreads();
}

constexpr int NPHASE = 23;

DI_ void gmlp_pre(const Params& p, int base, const float* hsrc, bf16_t* smem) {
  unsigned char* ws = p.ws;
  convT_phase<MAP_GMLP>(p.in[base + 1], 1024, 6144, 6144, p.in[base + 0], (bf16_t*)(ws + W_OFF), (float*)smem);
  convT_phase<MAP_IDENT>(p.in[base + 6], 2048, 1024, 1024, nullptr, (bf16_t*)(ws + W_OFF + 12 * MiB), (float*)smem);
  rownorm_phase(hsrc, (bf16_t*)(ws + HB_OFF));
}

__global__ void __launch_bounds__(512, 2) mega_kernel(Params p, int ph_lo, int ph_hi) {
  extern __shared__ __attribute__((aligned(16))) unsigned char smem_raw[];
  bf16_t* smem = (bf16_t*)smem_raw;
  cg::grid_group grid = cg::this_grid();
  volatile LAS unsigned* xbst = (volatile LAS unsigned*)(smem_raw + SMEM_MAIN + 2048);
  if (threadIdx.x == 0) { xbst[0] = 0u; xbst[1] = 0u; }
  __syncthreads();
  XcdBarrier xb = xcd_barrier_post((unsigned*)(p.ws + BAR_OFF), xbst);
  if (ph_lo < 0) grid.sync();
#define WSP(T, off) ((T*)(p.ws + (size_t)(off)))
#define HB WSP(bf16_t, HB_OFF)
#define B1 WSP(bf16_t, B1_OFF)
#define B2 WSP(bf16_t, B2_OFF)
#define B3 WSP(bf16_t, B3_OFF)
#define gWin WSP(bf16_t, W_OFF)
#define gWout WSP(bf16_t, W_OFF + 12 * MiB)
#define sWin WSP(bf16_t, W_OFF)
#define sWg WSP(bf16_t, 8 * MiB)
#define sYg WSP(bf16_t, 16 * MiB)
#define sWglu WSP(bf16_t, 40 * MiB)
#define sWout WSP(bf16_t, 48 * MiB)
#define sLam WSP(float, 52 * MiB)
#define mWin WSP(bf16_t, W_OFF)
#define mWq WSP(bf16_t, 6 * MiB)
#define mWuv WSP(bf16_t, 9 * MiB)
#define mWout WSP(bf16_t, 10 * MiB)
#define mCq WSP(bf16_t, 14 * MiB)
#define mCkv WSP(float, 26 * MiB)
#define mKc WSP(bf16_t, 34 * MiB)
#define mKcT WSP(bf16_t, 40 * MiB)
#define mQssq WSP(float, 44 * MiB)
#define mCos WSP(float, 45 * MiB)
#define mSin WSP(float, 47 * MiB)
#define mQp B1
#define mZ WSP(bf16_t, 192 * MiB)
#define h (p.out)

#ifndef ONLY
#define ONLY -1
#endif
#ifndef OLO
#define OLO 0
#define OHI 99
#endif
#ifndef EXCL
#define EXCL -1
#endif
#define PH(n) if ((ONLY < 0 || ONLY == n) && (n >= OLO && n <= OHI) && n != EXCL && ph_lo <= n && n < ph_hi)
#define SY(n) if (ph_lo <= n && n + 1 < ph_hi) xcd_barrier(xb);
  PH(0) {
    gmlp_pre(p, 2, p.in[0], smem);
  }
  SY(0)
  PH(1) {
    gmlp_in_phase(HB, gWin, B1, B2, (float*)B3, smem);
  }
  SY(1)
  PH(2) {
    gmlp_gate_phase(p.in[6], p.in[7], p.in[4], p.in[5], B2, (const float*)B3, B1, smem);
  }
  SY(2)
  PH(3) {
    out_phase(B1, gWout, p.in[0], h, smem);
  }
  SY(3)
  PH(4) {
    convT_phase<MAP_IDENT>(p.in[10], 1024, 4096, 4096, p.in[9], sWin, (float*)smem);
        convT_phase<MAP_IDENT>(p.in[19], 2048, 2048, 2048, nullptr, sWglu, (float*)smem);
        convT_phase<MAP_IDENT>(p.in[21], 2048, 1024, 1024, nullptr, sWout, (float*)smem);
        ssm_pre_phase(p, (float*)smem, sWg, sYg, sLam);
        rownorm_phase(h, HB);
  }
  SY(4)
  PH(5) {
    s5_inu_phase(HB, sWin, B1, smem);
  }
  SY(5)
  PH(6) {
    s5_sgemm_phase(B1, sWg, sLam, B3, smem);
  }
  SY(6)
  PH(8) {
    s5_ygemm_phase(B1, B3, sYg, B2, smem);
  }
  SY(8)
  PH(10) {
    s5_glu_phase(HB, sWin + (size_t)2048 * DM, B2, sWglu, p.in[20], B1, smem);
  }
  SY(10)
  PH(11) {
    out_phase(B1, sWout, h, h, smem);
  }
  SY(11)
  PH(12) {
    convT_phase<MAP_MLA>(p.in[23], 1024, 2624, 2816, p.in[22], mWin, (float*)smem);
        convT_phase<MAP_UV>(p.in[27], 128, 4096, 2048, p.in[26], mWuv, (float*)smem);
        convT_phase<MAP_IDENT>(p.in[28], 2048, 1024, 1024, nullptr, mWout, (float*)smem);
        mla_wq_phase(p.in[25], p.in[27], p.in[24], p.in[26], mWq, (float*)smem);
        rope_table_phase((const int*)p.in[1], mCos, mSin);
        rownorm_phase(h, HB);
  }
  SY(12)
  PH(13) {
    mla_in_phase(HB, mWin, mCq, mQssq, mCkv, mKc, mZ, mCos, mSin, smem);
  }
  SY(13)
  PH(14) {
    mla_q_phase(mCq, mQssq, mWq, mQp, mCos, mSin, mCkv, mKc, mKcT, smem);
  }
  SY(14)
  PH(15) {
    mla_attn_phase(mQp, mKc, mKcT, mWuv, mZ, smem);
  }
  SY(15)
  PH(17) {
    out_phase(mZ, mWout, h, h, smem);
  }
  SY(17)
  PH(18) {
    gmlp_pre(p, 29, h, smem);
  }
  SY(18)
  PH(19) {
    gmlp_in_phase(HB, gWin, B1, B2, (float*)B3, smem);
  }
  SY(19)
  PH(20) {
    gmlp_gate_phase(p.in[33], p.in[34], p.in[31], p.in[32], B2, (const float*)B3, B1, smem);
  }
  SY(20)
  PH(21) {
    out_phase(B1, gWout, h, h, smem);
  }
  SY(21)
  PH(22) {
    finalnorm_phase(h, p.in[36]);
  }
  SY(22)
}

extern "C" void kernel_launch(void* const* d_in, const int* in_sizes, int n_in, void* d_out, int out_size, void* d_ws, size_t ws_size,
                              hipStream_t stream) {
  static int grid_blocks = 0;
  if (!grid_blocks) {
    int dev = 0, cus = 0, per_cu = 0;
    hipGetDevice(&dev);
    hipDeviceGetAttribute(&cus, hipDeviceAttributeMultiprocessorCount, dev);
    hipFuncSetAttribute((const void*)mega_kernel, hipFuncAttributeMaxDynamicSharedMemorySize, SMEM_BYTES);
    hipOccupancyMaxActiveBlocksPerMultiprocessor(&per_cu, (const void*)mega_kernel, NT, SMEM_BYTES);
    if (per_cu > 1) per_cu = 1;
    if (per_cu < 1) per_cu = 1;
    grid_blocks = cus * per_cu;
  }
  Params p{};
  for (int i = 0; i < 37 && i < n_in; ++i) p.in[i] = (const float*)d_in[i];
  p.out = (float*)d_out;
  p.ws = (unsigned char*)d_ws;
  hipMemsetAsync((unsigned char*)d_ws + BAR_OFF, 0, XCD_BAR_WORDS * 4, stream);
  int lo = 0, hi = NPHASE;
  void* args[] = {&p, &lo, &hi};
  hipError_t e = hipLaunchCooperativeKernel((const void*)mega_kernel, dim3(grid_blocks), dim3(NT), args, SMEM_BYTES, stream);
  if (e != hipSuccess) fprintf(stderr, "cooperative launch failed: %s (grid %d)\n", hipGetErrorString(e), grid_blocks);
}
```

```cpp
#include <hip/hip_runtime.h>
#include <hip/hip_cooperative_groups.h>
#include <stdint.h>
#include <stdio.h>
namespace cg = cooperative_groups;

typedef unsigned short bf16_t;
typedef __attribute__((ext_vector_type(8))) short bf16x8;
typedef __attribute__((ext_vector_type(16))) float f32x16;
typedef __attribute__((ext_vector_type(4))) unsigned u32x4;

#define DI_ __device__ __forceinline__
#define MFMA32(a, b, c) __builtin_amdgcn_mfma_f32_32x32x16_bf16((a), (b), (c), 0, 0, 0)

constexpr int T_TOK = 16384;
constexpr int DM = 1024;
constexpr int DIN = 2048;
constexpr int SEQ = 4096;
constexpr int LDS_STRIDE = 72;
constexpr int TILE_E = 128 * LDS_STRIDE;
constexpr int NT = 512;
constexpr int SMEM_MAIN = 2 * 512 * LDS_STRIDE * 2;
constexpr int SMEM_BYTES = SMEM_MAIN + 2048 + 16;
constexpr size_t BAR_OFF = 62ull << 20;
constexpr size_t MiB = 1ull << 20;

constexpr size_t W_OFF = 0, HB_OFF = 64 * MiB, B1_OFF = 96 * MiB, B2_OFF = 160 * MiB, B3_OFF = 224 * MiB;

struct Params {
  const float* in[37];
  float* out;
  unsigned char* ws;
};

__device__ const float INVF[32] = {
  1.000000000e+00f, 7.498942614e-01f, 5.623413324e-01f, 4.216965139e-01f, 3.162277639e-01f, 2.371373773e-01f, 1.778279394e-01f, 1.333521307e-01f,
  1.000000015e-01f, 7.498941571e-02f, 5.623413250e-02f, 4.216965288e-02f, 3.162277490e-02f, 2.371373773e-02f, 1.778279431e-02f, 1.333521493e-02f,
  9.999999776e-03f, 7.498941850e-03f, 5.623413250e-03f, 4.216964822e-03f, 3.162277630e-03f, 2.371373586e-03f, 1.778279431e-03f, 1.333521446e-03f,
  1.000000047e-03f, 7.498942432e-04f, 5.623413017e-04f, 4.216965172e-04f, 3.162277571e-04f, 2.371373703e-04f, 1.778279402e-04f, 1.333521504e-04f};

typedef float f32x2 __attribute__((ext_vector_type(2)));
typedef __bf16 bf16x2_t __attribute__((ext_vector_type(2)));
DI_ unsigned short f2bf(float x) { __bf16 h = (__bf16)x; return __builtin_bit_cast(unsigned short, h); }
DI_ float bf2f(unsigned short b) { return __uint_as_float(((unsigned)b) << 16); }
DI_ unsigned pack2(float a, float b) { f32x2 v; v[0] = a; v[1] = b; return __builtin_bit_cast(unsigned, __builtin_convertvector(v, bf16x2_t)); }
DI_ float sigmoidf_(float x) { return __builtin_amdgcn_rcpf(1.f + __expf(-x)); }
DI_ float siluf_(float x) { return x * sigmoidf_(x); }
DI_ float geluf_(float x) { float y = 1.5957691216057308f * (x + 0.044715f * x * x * x); return x * sigmoidf_(y); }
DI_ int crow(int i, int hf) { return (i & 3) + 8 * (i >> 2) + 4 * hf; }
DI_ float red32(float v) { v += __shfl_xor(v, 1); v += __shfl_xor(v, 2); v += __shfl_xor(v, 4); v += __shfl_xor(v, 8); v += __shfl_xor(v, 16); return v; }
DI_ float red64(float v) { v = red32(v); v += __shfl_xor(v, 32); return v; }
DI_ void sincos_red(float x, float* s, float* c) {
  double xd = (double)x;
  double k = rint(xd * 0.15915494309189535);
  float r = (float)(xd - k * 6.283185307179586);
  *s = __sinf(r); *c = __cosf(r);
}

struct GemmArgs {
  const bf16_t* A1; int lda1;
  const bf16_t* A2; int lda2; int kt_split;
  const bf16_t* Bt; int ldb; int nkt;
};

template <int WM, int WN, int MI, int NI>
DI_ void gemm_compute_sw(const bf16_t* As, const bf16_t* Bs, int wm, int wn, int r, int hf, f32x16 (&acc)[MI][NI]) {
  bf16x8 a[2][MI], b[2][NI];
  int ao[MI], ax[MI], bo[NI], bx[NI];
#pragma unroll
  for (int mi = 0; mi < MI; ++mi) { const int R = wm * MI * 32 + mi * 32 + r; ao[mi] = R * 64; ax[mi] = (R >> 1) & 7; }
#pragma unroll
  for (int ni = 0; ni < NI; ++ni) { const int R = wn * NI * 32 + ni * 32 + r; bo[ni] = R * 64; bx[ni] = (R >> 1) & 7; }
#pragma unroll
  for (int mi = 0; mi < MI; ++mi) a[0][mi] = *(const bf16x8*)(As + ao[mi] + ((hf ^ ax[mi]) * 8));
#pragma unroll
  for (int ni = 0; ni < NI; ++ni) b[0][ni] = *(const bf16x8*)(Bs + bo[ni] + ((hf ^ bx[ni]) * 8));
#pragma unroll
  for (int ks = 0; ks < 4; ++ks) {
    if (ks < 3) {
#pragma unroll
      for (int mi = 0; mi < MI; ++mi) a[(ks + 1) & 1][mi] = *(const bf16x8*)(As + ao[mi] + ((((ks + 1) * 2 + hf) ^ ax[mi]) * 8));
#pragma unroll
      for (int ni = 0; ni < NI; ++ni) b[(ks + 1) & 1][ni] = *(const bf16x8*)(Bs + bo[ni] + ((((ks + 1) * 2 + hf) ^ bx[ni]) * 8));
    }
#pragma unroll
    for (int mi = 0; mi < MI; ++mi)
#pragma unroll
      for (int ni = 0; ni < NI; ++ni) acc[mi][ni] = MFMA32(a[ks & 1][mi], b[ks & 1][ni], acc[mi][ni]);
    __builtin_amdgcn_sched_barrier(0);
  }
}

template <int WM, int WN, int MI, int NI>
DI_ void gemm_compute(const bf16_t* As, const bf16_t* Bs, int wm, int wn, int r, int hf, f32x16 (&acc)[MI][NI]) {
#pragma unroll
  for (int ks = 0; ks < 4; ++ks) {
    bf16x8 a[MI], b[NI];
#pragma unroll
    for (int mi = 0; mi < MI; ++mi) a[mi] = *(const bf16x8*)(As + (wm * MI * 32 + mi * 32 + r) * LDS_STRIDE + ks * 16 + hf * 8);
#pragma unroll
    for (int ni = 0; ni < NI; ++ni) b[ni] = *(const bf16x8*)(Bs + (wn * NI * 32 + ni * 32 + r) * LDS_STRIDE + ks * 16 + hf * 8);
#pragma unroll
    for (int mi = 0; mi < MI; ++mi)
#pragma unroll
      for (int ni = 0; ni < NI; ++ni) acc[mi][ni] = MFMA32(a[mi], b[ni], acc[mi][ni]);
  }
}

template <int WM, int WN, int MI, int NI, bool ZERO = true>
DI_ void gemm_mainloop(const GemmArgs& g, bf16_t* smem, f32x16 (&acc)[MI][NI]) {
  constexpr int BM = WM * MI * 32, BN = WN * NI * 32;
  constexpr int ATILE = BM * 64, STAGE = (BM + BN) * 64;
  constexpr int ACH = BM / 64, BCH = BN / 64, NPC = ACH + BCH, PPK = (NPC + 1) / 2;
  int tid_ = threadIdx.x; asm volatile("" : "+v"(tid_));
  const int tid = tid_, lane = tid & 63, w = tid >> 6, wm = w / WN, wn = w % WN;
  const int r = lane & 31, hf = lane >> 5;
  const int lrow = tid >> 3;
  const int gc = ((tid & 7) ^ ((lrow >> 1) & 7)) * 8;
  if (ZERO) {
#pragma unroll
    for (int mi = 0; mi < MI; ++mi)
#pragma unroll
      for (int ni = 0; ni < NI; ++ni)
#pragma unroll
        for (int i = 0; i < 16; ++i) acc[mi][ni][i] = 0.f;
  }
  const int key = (r >> 1) & 7;
  const int abase = (wm * MI * 32 + r) * 64, bbase = ATILE + (wn * NI * 32 + r) * 64;
  const int koff0 = ((0 + hf) ^ key) * 8, koff1 = ((2 + hf) ^ key) * 8, koff2 = ((4 + hf) ^ key) * 8, koff3 = ((6 + hf) ^ key) * 8;
  __syncthreads();
  {
    const bf16_t* a; int lda;
    if (0 < g.kt_split) { a = g.A1; lda = g.lda1; } else { a = g.A2; lda = g.lda2; }
    const int toffa = lrow * lda + gc, toffb = lrow * g.ldb + gc;
#pragma unroll
    for (int i = 0; i < ACH; ++i)
      __builtin_amdgcn_global_load_lds((const unsigned*)(a + (size_t)i * 64 * lda + toffa), (unsigned*)(smem + (i * NT + tid) * 8), 16, 0, 0);
#pragma unroll
    for (int i = 0; i < BCH; ++i)
      __builtin_amdgcn_global_load_lds((const unsigned*)(g.Bt + (size_t)i * 64 * g.ldb + toffb), (unsigned*)(smem + ATILE + (i * NT + tid) * 8), 16, 0, 0);
  }
  __syncthreads();
  bf16x8 a[2][MI], b[2][NI];
#pragma unroll
  for (int mi = 0; mi < MI; ++mi) a[0][mi] = *(const bf16x8*)(smem + abase + mi * 2048 + koff0);
#pragma unroll
  for (int ni = 0; ni < NI; ++ni) b[0][ni] = *(const bf16x8*)(smem + bbase + ni * 2048 + koff0);
  for (int kt = 0; kt < g.nkt; ++kt) {
    const bool more = (kt + 1 < g.nkt);
    const int k1 = kt + 1;
    const bf16_t* an; int ldan;
    if (k1 < g.kt_split) { an = g.A1 + k1 * 64; ldan = g.lda1; } else { an = g.A2 + (k1 - g.kt_split) * 64; ldan = g.lda2; }
    const bf16_t* bn = g.Bt + k1 * 64;
    const int toffa = lrow * ldan + gc, toffb = lrow * g.ldb + gc;
    bf16_t* Sn = smem + (k1 & 1) * STAGE;
    const bf16_t* Sc = smem + (kt & 1) * STAGE;
#pragma unroll
    for (int ks = 0; ks < 4; ++ks) {
      if (more) {
#pragma unroll
        for (int q = 0; q < PPK; ++q) {
          const int j = ks * PPK + q;
          if (j < ACH)
            __builtin_amdgcn_global_load_lds((const unsigned*)(an + (size_t)j * 64 * ldan + toffa), (unsigned*)(Sn + (j * NT + tid) * 8), 16, 0, 0);
          else if (j < NPC)
            __builtin_amdgcn_global_load_lds((const unsigned*)(bn + (size_t)(j - ACH) * 64 * g.ldb + toffb), (unsigned*)(Sn + ATILE + ((j - ACH) * NT + tid) * 8), 16, 0, 0);
        }
      }
      if (ks < 3) {
        const int ko = (ks == 0) ? koff1 : (ks == 1) ? koff2 : koff3;
#pragma unroll
        for (int mi = 0; mi < MI; ++mi) a[(ks + 1) & 1][mi] = *(const bf16x8*)(Sc + abase + mi * 2048 + ko);
#pragma unroll
        for (int ni = 0; ni < NI; ++ni) b[(ks + 1) & 1][ni] = *(const bf16x8*)(Sc + bbase + ni * 2048 + ko);
      } else {
        __syncthreads();
        if (more) {
#pragma unroll
          for (int mi = 0; mi < MI; ++mi) a[0][mi] = *(const bf16x8*)(Sn + abase + mi * 2048 + koff0);
#pragma unroll
          for (int ni = 0; ni < NI; ++ni) b[0][ni] = *(const bf16x8*)(Sn + bbase + ni * 2048 + koff0);
        }
      }
      __builtin_amdgcn_sched_barrier(0);
#pragma unroll
      for (int mi = 0; mi < MI; ++mi)
#pragma unroll
        for (int ni = 0; ni < NI; ++ni) acc[mi][ni] = MFMA32(a[ks & 1][mi], b[ks & 1][ni], acc[mi][ni]);
      __builtin_amdgcn_sched_barrier(0);
    }
  }
}

typedef __attribute__((ext_vector_type(4))) float f32x4;
#define MFMA16(a, b, c) __builtin_amdgcn_mfma_f32_16x16x32_bf16((a), (b), (c), 0, 0, 0)
template <int WM, int WN, int MT, int NQ>
DI_ void gemm_mainloop16(const GemmArgs& gr, bf16_t* smem, f32x4 (&acc)[MT][NQ]) {
  struct { const bf16_t* A1; int lda1; const bf16_t* A2; int lda2; int kt_split; const bf16_t* Bt; int ldb; int nkt; } g;
  g.A1 = gr.A1; g.lda1 = gr.lda1; g.A2 = gr.A2 ? gr.A2 : gr.A1; g.lda2 = gr.A2 ? gr.lda2 : gr.lda1; g.kt_split = gr.kt_split; g.Bt = gr.Bt; g.ldb = gr.ldb; g.nkt = gr.nkt;
  constexpr int BM = WM * MT * 16, BN = WN * NQ * 16;
  constexpr int ATILE = BM * 64, STAGE = (BM + BN) * 64;
  constexpr int ACH = BM / 64, BCH = BN / 64, NPC = ACH + BCH, PPK = (NPC + 1) / 2;
  int tid_ = threadIdx.x; asm volatile("" : "+v"(tid_));
  const int tid = tid_, lane = tid & 63, w = tid >> 6, wm = w / WN, wn = w % WN;
  const int r16 = lane & 15, quad = lane >> 4;
  const int lrow = tid >> 3;
  const int gc = ((tid & 7) ^ ((lrow >> 1) & 7)) * 8;
#pragma unroll
  for (int mt = 0; mt < MT; ++mt)
#pragma unroll
    for (int nq = 0; nq < NQ; ++nq)
#pragma unroll
      for (int j = 0; j < 4; ++j) acc[mt][nq][j] = 0.f;
  const int key = (r16 >> 1) & 7;
  const int abase = (wm * MT * 16 + r16) * 64, bbase = ATILE + (wn * NQ * 16 + r16) * 64;
  const int koff0 = ((0 + quad) ^ key) * 8, koff1 = ((4 + quad) ^ key) * 8;
  __syncthreads();
  {
    const bf16_t* a0 = (0 < g.kt_split) ? g.A1 : g.A2;
    const int lda0 = (0 < g.kt_split) ? g.lda1 : g.lda2;
    const int toffa = lrow * lda0 + gc, toffb = lrow * g.ldb + gc;
#pragma unroll
    for (int i = 0; i < ACH; ++i)
      __builtin_amdgcn_global_load_lds((const unsigned*)(a0 + (size_t)i * 64 * lda0 + toffa), (unsigned*)(smem + (i * NT + tid) * 8), 16, 0, 0);
#pragma unroll
    for (int i = 0; i < BCH; ++i)
      __builtin_amdgcn_global_load_lds((const unsigned*)(g.Bt + (size_t)i * 64 * g.ldb + toffb), (unsigned*)(smem + ATILE + (i * NT + tid) * 8), 16, 0, 0);
  }
  __syncthreads();
#pragma unroll 1
  for (int kt = 0; kt < g.nkt; ++kt) {
    const bool more = (kt + 1 < g.nkt);
    const int k1 = kt + 1;
    const bool first = k1 < g.kt_split;
    const bf16_t* an = (first ? g.A1 : g.A2) + (first ? k1 : k1 - g.kt_split) * 64;
    const int ldan = first ? g.lda1 : g.lda2;
    const bf16_t* bn = g.Bt + k1 * 64;
    const int toffa = lrow * ldan + gc, toffb = lrow * g.ldb + gc;
    bf16_t* Sn = smem + (k1 & 1) * STAGE;
    const bf16_t* Sc = smem + (kt & 1) * STAGE;
    __builtin_amdgcn_iglp_opt(0);
#pragma unroll
    for (int ks = 0; ks < 2; ++ks) {
      if (more) {
#pragma unroll
        for (int q = 0; q < PPK; ++q) {
          const int j = ks * PPK + q;
          if (j < ACH)
            __builtin_amdgcn_global_load_lds((const unsigned*)(an + (size_t)j * 64 * ldan + toffa), (unsigned*)(Sn + (j * NT + tid) * 8), 16, 0, 0);
          else if (j < NPC)
            __builtin_amdgcn_global_load_lds((const unsigned*)(bn + (size_t)(j - ACH) * 64 * g.ldb + toffb), (unsigned*)(Sn + ATILE + ((j - ACH) * NT + tid) * 8), 16, 0, 0);
        }
      }
      const int ko = ks ? koff1 : koff0;
      bf16x8 a[MT], b[NQ];
#pragma unroll
      for (int mt = 0; mt < MT; ++mt) a[mt] = *(const bf16x8*)(Sc + abase + mt * 1024 + ko);
#pragma unroll
      for (int nq = 0; nq < NQ; ++nq) b[nq] = *(const bf16x8*)(Sc + bbase + nq * 1024 + ko);
#pragma unroll
      for (int mt = 0; mt < MT; ++mt)
#pragma unroll
        for (int nq = 0; nq < NQ; ++nq) acc[mt][nq] = MFMA16(a[mt], b[nq], acc[mt][nq]);
    }
    __syncthreads();
  }
}

template <int WM, int WN, int MT, int NQ>
DI_ void gemm_mainloop16s(const GemmArgs& gr, bf16_t* smem, f32x4 (&acc)[MT][NQ]) {
  struct { const bf16_t* A1; int lda1; const bf16_t* A2; int lda2; int kt_split; const bf16_t* Bt; int ldb; int nkt; } g;
  g.A1 = gr.A1; g.lda1 = gr.lda1; g.A2 = gr.A2 ? gr.A2 : gr.A1; g.lda2 = gr.A2 ? gr.lda2 : gr.lda1; g.kt_split = gr.kt_split; g.Bt = gr.Bt; g.ldb = gr.ldb; g.nkt = gr.nkt;
  constexpr int BM = WM * MT * 16, BN = WN * NQ * 16;
  constexpr int ATILE = BM * 64, STAGE = (BM + BN) * 64;
  constexpr int ACH = BM / 64, BCH = BN / 64, NPC = ACH + BCH, PPK = (NPC + 1) / 2;
  int tid_ = threadIdx.x; asm volatile("" : "+v"(tid_));
  const int tid = tid_, lane = tid & 63, w = tid >> 6, wm = w / WN, wn = w % WN;
  const int r16 = lane & 15, quad = lane >> 4;
  const int lrow = tid >> 3;
  const int gc = ((tid & 7) ^ ((lrow >> 1) & 7)) * 8;
#pragma unroll
  for (int mt = 0; mt < MT; ++mt)
#pragma unroll
    for (int nq = 0; nq < NQ; ++nq)
#pragma unroll
      for (int j = 0; j < 4; ++j) acc[mt][nq][j] = 0.f;
  const int key = (r16 >> 1) & 7;
  const int abase = (wm * MT * 16 + r16) * 64, bbase = ATILE + (wn * NQ * 16 + r16) * 64;
  const int koff0 = ((0 + quad) ^ key) * 8, koff1 = ((4 + quad) ^ key) * 8;
  __syncthreads();
  {
    const bf16_t* a0 = (0 < g.kt_split) ? g.A1 : g.A2;
    const int lda0 = (0 < g.kt_split) ? g.lda1 : g.lda2;
    const int toffa = lrow * lda0 + gc, toffb = lrow * g.ldb + gc;
#pragma unroll
    for (int i = 0; i < ACH; ++i)
      __builtin_amdgcn_global_load_lds((const unsigned*)(a0 + (size_t)i * 64 * lda0 + toffa), (unsigned*)(smem + (i * NT + tid) * 8), 16, 0, 0);
#pragma unroll
    for (int i = 0; i < BCH; ++i)
      __builtin_amdgcn_global_load_lds((const unsigned*)(g.Bt + (size_t)i * 64 * g.ldb + toffb), (unsigned*)(smem + ATILE + (i * NT + tid) * 8), 16, 0, 0);
  }
  __syncthreads();
#pragma unroll 1
  for (int kt = 0; kt < g.nkt; ++kt) {
    const bool more = (kt + 1 < g.nkt);
    const int k1 = kt + 1;
    const bool first = k1 < g.kt_split;
    const bf16_t* an = (first ? g.A1 : g.A2) + (first ? k1 : k1 - g.kt_split) * 64;
    const int ldan = first ? g.lda1 : g.lda2;
    const bf16_t* bn = g.Bt + k1 * 64;
    const int toffa = lrow * ldan + gc, toffb = lrow * g.ldb + gc;
    bf16_t* Sn = smem + (k1 & 1) * STAGE;
    const bf16_t* Sc = smem + (kt & 1) * STAGE;
#pragma unroll
    for (int ks = 0; ks < 2; ++ks) {
      if (more) {
#pragma unroll
        for (int q = 0; q < PPK; ++q) {
          const int j = ks * PPK + q;
          if (j < ACH)
            __builtin_amdgcn_global_load_lds((const unsigned*)(an + (size_t)j * 64 * ldan + toffa), (unsigned*)(Sn + (j * NT + tid) * 8), 16, 0, 0);
          else if (j < NPC)
            __builtin_amdgcn_global_load_lds((const unsigned*)(bn + (size_t)(j - ACH) * 64 * g.ldb + toffb), (unsigned*)(Sn + ATILE + ((j - ACH) * NT + tid) * 8), 16, 0, 0);
        }
      }
      const int ko = ks ? koff1 : koff0;
      bf16x8 a[MT], b[NQ];
#pragma unroll
      for (int mt = 0; mt < MT; ++mt) a[mt] = *(const bf16x8*)(Sc + abase + mt * 1024 + ko);
#pragma unroll
      for (int nq = 0; nq < NQ; ++nq) b[nq] = *(const bf16x8*)(Sc + bbase + nq * 1024 + ko);
#pragma unroll
      for (int mt = 0; mt < MT; ++mt)
#pragma unroll
        for (int nq = 0; nq < NQ; ++nq) acc[mt][nq] = MFMA16(a[mt], b[nq], acc[mt][nq]);
      __builtin_amdgcn_sched_barrier(0);
    }
    __syncthreads();
  }
}

template <int ROWS> DI_ bf16_t* wave_stage(bf16_t* smem, int w) { return smem + w * ROWS * LDS_STRIDE; }
DI_ void stage_sync() { asm volatile("s_waitcnt lgkmcnt(0)" ::: "memory"); __builtin_amdgcn_wave_barrier(); }
template <int ROWS, int COLS> DI_ void stage_flush(const bf16_t* st, bf16_t* out, size_t ld, int lane) {
  constexpr int CPR = COLS / 8, RPI = 64 / CPR;
  stage_sync();
#pragma unroll 4
  for (int it = 0; it < ROWS / RPI; ++it) {
    const int row = it * RPI + lane / CPR, ch = lane % CPR;
    const uint4 v = *(const uint4*)(st + row * LDS_STRIDE + ch * 8);
    *(uint4*)(out + (size_t)row * ld + ch * 8) = v;
  }
  stage_sync();
}

template <int ROWS, int COLS> DI_ void stage_load(bf16_t* st, const bf16_t* in, size_t ld, int lane) {
  constexpr int CPR = COLS / 8, RPI = 64 / CPR;
#pragma unroll 4
  for (int it = 0; it < ROWS / RPI; ++it) {
    const int row = it * RPI + lane / CPR, ch = lane % CPR;
    const uint4 v = *(const uint4*)(in + (size_t)row * ld + ch * 8);
    *(uint4*)(st + row * LDS_STRIDE + ch * 8) = v;
  }
  stage_sync();
}
template <int ROWS, class F> DI_ void stage_rowstats(const bf16_t* st, int lane, F f) {
  stage_sync();
#pragma unroll 2
  for (int it = 0; it < ROWS / 8; ++it) {
    const int row = it * 8 + (lane >> 3), ch = lane & 7;
    const uint4 v = *(const uint4*)(st + row * LDS_STRIDE + ch * 8);
    const unsigned u[4] = {v.x, v.y, v.z, v.w};
    float s1 = 0.f, s2 = 0.f;
#pragma unroll
    for (int j = 0; j < 4; ++j) {
      const float a = __uint_as_float(u[j] << 16), b = __uint_as_float(u[j] & 0xffff0000u);
      s1 += a + b; s2 += a * a + b * b;
    }
    s1 += __shfl_xor(s1, 1); s2 += __shfl_xor(s2, 1);
    s1 += __shfl_xor(s1, 2); s2 += __shfl_xor(s2, 2);
    s1 += __shfl_xor(s1, 4); s2 += __shfl_xor(s2, 4);
    if (ch == 0) f(row, s1, s2);
  }
}

#define TILE_IDS() int tid_ = threadIdx.x; asm volatile("" : "+v"(tid_)); const int tid = tid_, lane = tid & 63, w = tid >> 6, r = lane & 31, hf = lane >> 5; (void)tid; (void)w; (void)r; (void)hf;
#define CFG_A() constexpr int WM = 2, WN = 4, MI = 4, NI = 2; const int wm = w / WN, wn = w % WN; (void)wm; (void)wn;
#define CFG_B() constexpr int WM = 4, WN = 2, MI = 2, NI = 2; const int wm = w / WN, wn = w % WN; (void)wm; (void)wn;
#define CFG_A16() constexpr int WM = 2, WN = 4, MT = 8, NQ = 4; const int wm = w / WN, wn = w % WN, r16 = lane & 15, quad = lane >> 4; (void)wm; (void)wn; (void)r16; (void)quad;
#define CFG_B16() constexpr int WM = 4, WN = 2, MT = 4, NQ = 4; const int wm = w / WN, wn = w % WN, r16 = lane & 15, quad = lane >> 4; (void)wm; (void)wn; (void)r16; (void)quad;
#define CFG_C() constexpr int WM = 2, WN = 4, MI = 2, NI = 2; const int wm = w / WN, wn = w % WN; (void)wm; (void)wn;

DI_ int norm_row_map(int rr) {
  return (gridDim.x == 256) ? ((((rr >> 3) & 7) + 8 * (rr >> 11)) << 8) + (((rr >> 6) & 31) << 3) + (rr & 7) : rr;
}
DI_ void rownorm_phase(const float* src, bf16_t* dst) {
  const int lane = threadIdx.x & 63;
  const int gw = blockIdx.x * 8 + (threadIdx.x >> 6), nw = gridDim.x * 8;
  for (int rr0 = gw; rr0 < T_TOK; rr0 += 4 * nw) {
    int row[4]; bool ok[4]; float4 v[4][4]; float ss[4];
#pragma unroll
    for (int k = 0; k < 4; ++k) { const int rr = rr0 + k * nw; ok[k] = rr < T_TOK; row[k] = norm_row_map(ok[k] ? rr : rr0); }
#pragma unroll
    for (int k = 0; k < 4; ++k) {
      const float4* s4 = (const float4*)(src + (size_t)row[k] * DM);
#pragma unroll
      for (int i = 0; i < 4; ++i) v[k][i] = s4[lane + i * 64];
    }
#pragma unroll
    for (int k = 0; k < 4; ++k) {
      float a_ = 0.f;
#pragma unroll
      for (int i = 0; i < 4; ++i) a_ += v[k][i].x * v[k][i].x + v[k][i].y * v[k][i].y + v[k][i].z * v[k][i].z + v[k][i].w * v[k][i].w;
      ss[k] = a_;
    }
#pragma unroll
    for (int k = 0; k < 4; ++k) ss[k] = red64(ss[k]);
#pragma unroll
    for (int k = 0; k < 4; ++k) {
      if (ok[k]) {
        const float rs = rsqrtf(ss[k] * (1.f / 1024.f) + 1e-6f);
#pragma unroll
        for (int i = 0; i < 4; ++i) {
          uint2 o; o.x = pack2(v[k][i].x * rs, v[k][i].y * rs); o.y = pack2(v[k][i].z * rs, v[k][i].w * rs);
          *(uint2*)(dst + (size_t)row[k] * DM + (lane + i * 64) * 4) = o;
        }
      }
    }
  }
}

DI_ void finalnorm_phase(float* h, const float* gain) {
  const int lane = threadIdx.x & 63;
  const int gw = blockIdx.x * 8 + (threadIdx.x >> 6), nw = gridDim.x * 8;
  const float4* g4 = (const float4*)gain;
  float4 gv[4];
#pragma unroll
  for (int i = 0; i < 4; ++i) gv[i] = g4[lane + i * 64];
  for (int rr0 = gw; rr0 < T_TOK; rr0 += 4 * nw) {
    int row[4]; bool ok[4]; float4 v[4][4]; float ss[4];
#pragma unroll
    for (int k = 0; k < 4; ++k) { const int rr = rr0 + k * nw; ok[k] = rr < T_TOK; row[k] = norm_row_map(ok[k] ? rr : rr0); }
#pragma unroll
    for (int k = 0; k < 4; ++k) {
      const float4* s4 = (const float4*)(h + (size_t)row[k] * DM);
#pragma unroll
      for (int i = 0; i < 4; ++i) v[k][i] = s4[lane + i * 64];
    }
#pragma unroll
    for (int k = 0; k < 4; ++k) {
      float a_ = 0.f;
#pragma unroll
      for (int i = 0; i < 4; ++i) a_ += v[k][i].x * v[k][i].x + v[k][i].y * v[k][i].y + v[k][i].z * v[k][i].z + v[k][i].w * v[k][i].w;
      ss[k] = a_;
    }
#pragma unroll
    for (int k = 0; k < 4; ++k) ss[k] = red64(ss[k]);
#pragma unroll
    for (int k = 0; k < 4; ++k) {
      if (ok[k]) {
        const float rs = rsqrtf(ss[k] * (1.f / 1024.f) + 1e-6f);
        float4* o4 = (float4*)(h + (size_t)row[k] * DM);
#pragma unroll
        for (int i = 0; i < 4; ++i) {
          float4 o; o.x = v[k][i].x * rs * gv[i].x; o.y = v[k][i].y * rs * gv[i].y; o.z = v[k][i].z * rs * gv[i].z; o.w = v[k][i].w * rs * gv[i].w;
          o4[lane + i * 64] = o;
        }
      }
    }
  }
}

enum { MAP_IDENT = 0, MAP_GMLP = 1, MAP_MLA = 2, MAP_UV = 3 };
template <int MAP> DI_ int colmap(int n) {
  if (MAP == MAP_IDENT) return n;
  if (MAP == MAP_GMLP) {
    if (n < 4096) { int wt = n >> 6, rr = n & 63; int ch = wt * 32 + (rr & 31); return (rr < 32) ? ch : 4096 + ch; }
    return 2048 + (n - 4096);
  }
  if (MAP == MAP_MLA) { if (n < 576) return n; if (n < 640 || n >= 2688) return -1; return n - 64; }
    return (n >> 7) * 256 + 128 + (n & 127);
}
template <int MAP> DI_ void convT_phase(const float* src, int K, int Nsrc, int Ndst, const float* gain, bf16_t* dst, float* tile) {
  const int tx = threadIdx.x & 63, ty = threadIdx.x >> 6;
  const int nkb = K >> 7, ntiles = nkb * (Ndst >> 6);
  for (int t = blockIdx.x; t < ntiles; t += gridDim.x) {
    const int kb = t % nkb, nb = t / nkb, k0 = kb * 128, n0 = nb * 64;
    const int l16 = threadIdx.x & 15, kr = threadIdx.x >> 4;
    const int sc = colmap<MAP>(n0 + 4 * l16);
    __syncthreads();
#pragma unroll
    for (int q = 0; q < 4; ++q) {
      const int kk = kr + q * 32;
      float4 v = (sc >= 0) ? *(const float4*)(src + (size_t)(k0 + kk) * Nsrc + sc) : make_float4(0.f, 0.f, 0.f, 0.f);
      if (gain) { const float gk = gain[k0 + kk]; v.x *= gk; v.y *= gk; v.z *= gk; v.w *= gk; }
      float* tp = tile + kk * 65 + 4 * l16;
      tp[0] = v.x; tp[1] = v.y; tp[2] = v.z; tp[3] = v.w;
    }
    __syncthreads();
#pragma unroll
    for (int q = 0; q < 8; ++q) {
      const int nn = ty + q * 8;
      const unsigned o = pack2(tile[(2 * tx) * 65 + nn], tile[(2 * tx + 1) * 65 + nn]);
      *(unsigned*)(dst + (size_t)(n0 + nn) * K + k0 + 2 * tx) = o;
    }
  }
}

DI_ void gmlp_in_phase(const bf16_t* HB, const bf16_t* WinT, bf16_t* UZ, bf16_t* VgT, float* vstat, bf16_t* smem) {
  TILE_IDS(); CFG_A16();
  for (int t = blockIdx.x; t < 64 * 24; t += gridDim.x) {
    const int q_ = t >> 3, mt_ = (t & 7) + 8 * (q_ & 7), nt = 4 * (q_ >> 5) + ((q_ >> 3) & 3);
    GemmArgs g{HB + (size_t)mt_ * 256 * DM, DM, nullptr, 0, 1 << 30, WinT + (size_t)nt * 256 * DM, DM, 16};
    f32x4 acc[MT][NQ];
    gemm_mainloop16<WM, WN, MT, NQ>(g, smem, acc);
    const int cb = nt * 4 + wn;
    bf16_t* st = wave_stage<128>(smem, w);
    if (cb < 64) {
#pragma unroll
      for (int mt = 0; mt < MT; ++mt)
#pragma unroll
        for (int nq = 0; nq < 2; ++nq)
#pragma unroll
          for (int j = 0; j < 4; ++j)
            st[(mt * 16 + quad * 4 + j) * LDS_STRIDE + nq * 16 + r16] = f2bf(geluf_(acc[mt][nq][j]) * siluf_(acc[mt][nq + 2][j]));
      stage_flush<128, 32>(st, UZ + (size_t)(mt_ * 256 + wm * 128) * DIN + cb * 32, DIN, lane);
    } else {
      const int cbv = cb - 64;
#pragma unroll
      for (int mt = 0; mt < MT; ++mt)
#pragma unroll
        for (int nq = 0; nq < NQ; ++nq) {
          const int d = cbv * 64 + nq * 16 + r16;
          const float v0 = geluf_(acc[mt][nq][0]), v1 = geluf_(acc[mt][nq][1]), v2 = geluf_(acc[mt][nq][2]), v3 = geluf_(acc[mt][nq][3]);
          uint2 o; o.x = pack2(v0, v1); o.y = pack2(v2, v3);
          *(uint2*)(VgT + ((size_t)(mt_ * 2 + wm) * DIN + d) * 128 + mt * 16 + quad * 4) = o;
          bf16_t* sp = st + (mt * 16 + quad * 4) * LDS_STRIDE + nq * 16 + r16;
          sp[0] = (bf16_t)(o.x & 0xffffu); sp[LDS_STRIDE] = (bf16_t)(o.x >> 16);
          sp[2 * LDS_STRIDE] = (bf16_t)(o.y & 0xffffu); sp[3 * LDS_STRIDE] = (bf16_t)(o.y >> 16);
        }
      const int rowg = mt_ * 256 + wm * 128;
      stage_rowstats<128>(st, lane, [&](int row, float s1, float s2) {
        float2 o; o.x = s1; o.y = s2;
        *(float2*)(vstat + ((size_t)(rowg + row) * 32 + cbv) * 2) = o;
      });
      stage_sync();
    }
  }
}

DI_ void gmlp_gate_phase(const float* w_s, const float* b_s, const float* ln_g, const float* ln_b,
                         const bf16_t* VgT, const float* vstat, bf16_t* UZ, bf16_t* smem) {
  TILE_IDS(); CFG_C();
  constexpr int ATILE = 128 * LDS_STRIDE, STAGE = 384 * LDS_STRIDE;
  float* ext = (float*)((unsigned char*)smem + SMEM_MAIN);
  for (int item = blockIdx.x; item < 1024; item += gridDim.x) {
    const int xk = item >> 3, g = xk & 7, chunk = (((item & 7) + 8 * (xk >> 4)) << 1) + ((xk >> 3) & 1);
    __syncthreads();
    if (tid < 128) {
      const float2* ps = (const float2*)(vstat + (size_t)(chunk * 128 + tid) * 64);
      float s1 = 0.f, s2 = 0.f;
      for (int j = 0; j < 32; ++j) { float2 v = ps[j]; s1 += v.x; s2 += v.y; }
      const float mu = s1 * (1.f / 2048.f);
      const float var = fmaxf(s2 * (1.f / 2048.f) - mu * mu, 0.f);
      ext[tid] = mu; ext[128 + tid] = rsqrtf(var + 1e-6f);
    }
    __syncthreads();
    {
      const int tp = tid >> 2, q = tid & 3;
      const float4* wrow = (const float4*)(w_s + (size_t)(g * 128 + tp) * 128 + q * 32);
      float r0 = 0.f, r1 = 0.f;
#pragma unroll 1
      for (int j8 = 0; j8 < 4; ++j8) {
        const float4 wa = wrow[j8 * 2], wb = wrow[j8 * 2 + 1];
        const float wv[8] = {wa.x, wa.y, wa.z, wa.w, wb.x, wb.y, wb.z, wb.w};
        float sc[8];
#pragma unroll
        for (int j = 0; j < 8; ++j) {
          const int tk = q * 32 + j8 * 8 + j;
          const float wm_ = (tk <= tp) ? wv[j] : 0.f;
          r0 += wm_;
          sc[j] = bf2f(f2bf(wm_ * ext[128 + tk]));
          r1 += sc[j] * ext[tk];
        }
        uint4 o; o.x = pack2(sc[0], sc[1]); o.y = pack2(sc[2], sc[3]); o.z = pack2(sc[4], sc[5]); o.w = pack2(sc[6], sc[7]);
        const int tk0 = q * 32 + j8 * 8;
        *(uint4*)(smem + (tk0 >> 6) * STAGE + tp * LDS_STRIDE + (tk0 & 63)) = o;
      }
      r0 += __shfl_xor(r0, 1); r0 += __shfl_xor(r0, 2);
      r1 += __shfl_xor(r1, 1); r1 += __shfl_xor(r1, 2);
      if (q == 0) { ext[256 + tp] = r0; ext[384 + tp] = r1; }
    }
#pragma unroll 2
    for (int i = 0; i < 8; ++i) {
      const int c = tid + i * NT, d = c >> 4, kc = c & 15;
      uint4 v = *(const uint4*)(VgT + ((size_t)chunk * DIN + g * 256 + d) * 128 + kc * 8);
      *(uint4*)(smem + (kc >> 3) * STAGE + ATILE + d * LDS_STRIDE + (kc & 7) * 8) = v;
    }
    __syncthreads();
    f32x16 acc[MI][NI];
#pragma unroll
    for (int mi = 0; mi < MI; ++mi)
#pragma unroll
      for (int ni = 0; ni < NI; ++ni)
#pragma unroll
        for (int i = 0; i < 16; ++i) acc[mi][ni][i] = 0.f;
    gemm_compute<WM, WN, MI, NI>(smem, smem + ATILE, wm, wn, r, hf, acc);
    gemm_compute<WM, WN, MI, NI>(smem + STAGE, smem + STAGE + ATILE, wm, wn, r, hf, acc);
    __syncthreads();
    {
      bf16_t* st = wave_stage<64>(smem, w);
      bf16_t* gp = UZ + (size_t)(chunk * 128 + wm * 64) * DIN + g * 256 + wn * 64;
      stage_load<64, 64>(st, gp, DIN, lane);
#pragma unroll
      for (int ni = 0; ni < NI; ++ni) {
        const int ch = g * 256 + wn * 64 + ni * 32 + r;
        const float lg = ln_g[ch], lb = ln_b[ch];
#pragma unroll
        for (int mi = 0; mi < MI; ++mi)
#pragma unroll
          for (int i = 0; i < 16; ++i) {
            const int tp = wm * 64 + mi * 32 + crow(i, hf);
            const float sv = lg * (acc[mi][ni][i] - ext[384 + tp]) + lb * ext[256 + tp] + b_s[g * 128 + tp];
            bf16_t* pz = st + (mi * 32 + crow(i, hf)) * LDS_STRIDE + ni * 32 + r;
            *pz = f2bf(bf2f(*pz) * sv);
            if (i == 15) asm volatile("" ::: "memory");
          }
      }
      stage_flush<64, 64>(st, gp, DIN, lane);
    }
  }
}

DI_ void out_phase(const bf16_t* A, const bf16_t* WoutT, const float* hin, float* hout, bf16_t* smem) {
  TILE_IDS();
  constexpr int WM = 2, WN = 4, MT = 8, NQ = 4;
  const int wm = w / WN, wn = w % WN, r16 = lane & 15, quad = lane >> 4;
  for (int t = blockIdx.x; t < 64 * 4; t += gridDim.x) {
    const int mt_ = (t & 7) + 8 * (t >> 5), nt = (t >> 3) & 3;
    GemmArgs g{A + (size_t)mt_ * 256 * DIN, DIN, nullptr, 0, 1 << 30, WoutT + (size_t)nt * 256 * DIN, DIN, 32};
    f32x4 acc[MT][NQ];
    gemm_mainloop16<WM, WN, MT, NQ>(g, smem, acc);
#pragma unroll
    for (int mt = 0; mt < MT; ++mt)
#pragma unroll
      for (int nq = 0; nq < NQ; ++nq)
#pragma unroll
        for (int j = 0; j < 4; ++j) {
          const size_t idx = (size_t)(mt_ * 256 + wm * 128 + mt * 16 + quad * 4 + j) * DM + nt * 256 + wn * 64 + nq * 16 + r16;
          hout[idx] = hin[idx] + acc[mt][nq][j];
        }
  }
}

DI_ void ssm_pre_phase(const Params& p, float* sm, bf16_t* WgT, bf16_t* YgT, float* lamL) {
  int tid_ = threadIdx.x; asm volatile("" : "+v"(tid_)); const int tid = tid_;
  const float *a_re = p.in[11], *a_im = p.in[12], *log_step = p.in[13], *b_re = p.in[14], *b_im = p.in[15];
  const float *c_re = p.in[16], *c_im = p.in[17], *d_skip = p.in[18];
  float* lp_re = sm;
  float* lp_im = sm + 17 * 64;
  float* bb_re = sm + 34 * 64;
  float* bb_im = bb_re + 1024;
  float* cc_re = bb_im + 1024;
  float* cc_im = cc_re + 1024;
  float* cf = cc_im + 1024;
  float* Kt = cf + 128;
  for (int item = blockIdx.x; item < 256; item += gridDim.x) {
    const int g = item >> 1, half = item & 1;
    __syncthreads();
    if (tid < 64) {
      const float st = expf(log_step[g]);
      const float ar = a_re[g * 64 + tid], ai = a_im[g * 64 + tid];
      const float zr = ar * st, zi = ai * st;
      for (int tau = 0; tau <= 16; ++tau) {
        float e = expf(zr * (float)tau), sn, cs;
        sincos_red(zi * (float)tau, &sn, &cs);
        lp_re[tau * 64 + tid] = e * cs; lp_im[tau * 64 + tid] = e * sn;
      }
      float sn, cs; sincos_red(zi, &sn, &cs);
      float sh, ch; sincos_red(0.5f * zi, &sh, &ch);
      const float em1 = expm1f(zr);
      const float nr = em1 * cs - 2.f * sh * sh, ni = (em1 + 1.f) * sn;
      const float den = 1.f / (ar * ar + ai * ai);
      cf[tid] = (nr * ar + ni * ai) * den; cf[64 + tid] = (ni * ar - nr * ai) * den;
    }
    __syncthreads();
    for (int e = tid; e < 1024; e += NT) {
      const int pp = e >> 4;
      const float br = b_re[(size_t)g * 1024 + e], bi = b_im[(size_t)g * 1024 + e];
      const float cr = cf[pp], ci = cf[64 + pp];
      bb_re[e] = cr * br - ci * bi; bb_im[e] = cr * bi + ci * br;
      cc_re[e] = c_re[(size_t)g * 1024 + e]; cc_im[e] = c_im[(size_t)g * 1024 + e];
    }
    __syncthreads();
    for (int e = tid; e < 4096; e += NT) {
      const int tau = e >> 8, ho = (e >> 4) & 15, hi = e & 15;
      float acc = 0.f;
      for (int pp = 0; pp < 64; ++pp) {
        const float cr = cc_re[ho * 64 + pp], ci = cc_im[ho * 64 + pp];
        const float lr = lp_re[tau * 64 + pp], li = lp_im[tau * 64 + pp];
        const float dr = cr * lr - ci * li, di = cr * li + ci * lr;
        acc += dr * bb_re[pp * 16 + hi] - di * bb_im[pp * 16 + hi];
      }
      if (tau == 0 && ho == hi) acc += d_skip[g * 16 + ho];
      Kt[e] = acc;
    }
    __syncthreads();
    for (int e = half * 32768 + tid; e < (half + 1) * 32768; e += NT) {
      const int n = e >> 8, k = e & 255, t = n >> 4, ho = n & 15, sx = k >> 4, hi = k & 15;
      const float v = (sx <= t) ? Kt[((t - sx) * 16 + ho) * 16 + hi] : 0.f;
      YgT[((size_t)g * 256 + n) * 384 + k] = f2bf(v);
    }
    for (int e = half * 8192 + tid; e < (half + 1) * 8192; e += NT) {
      const int n = e >> 6, pp = e & 63, t = n >> 4, ho = n & 15;
      const float cr = cc_re[ho * 64 + pp], ci = cc_im[ho * 64 + pp];
      const float lr = lp_re[(t + 1) * 64 + pp], li = lp_im[(t + 1) * 64 + pp];
      YgT[((size_t)g * 256 + n) * 384 + 256 + pp] = f2bf(cr * lr - ci * li);
      YgT[((size_t)g * 256 + n) * 384 + 320 + pp] = f2bf(-(cr * li + ci * lr));
    }
    for (int e = half * 8192 + tid; e < (half + 1) * 8192; e += NT) {
      const int pp = e >> 8, k = e & 255, j = k >> 4, hh = k & 15;
      const float lr = lp_re[(15 - j) * 64 + pp], li = lp_im[(15 - j) * 64 + pp];
      const float br = bb_re[pp * 16 + hh], bi = bb_im[pp * 16 + hh];
      WgT[((size_t)g * 128 + pp) * 256 + k] = f2bf(lr * br - li * bi);
      WgT[((size_t)g * 128 + 64 + pp) * 256 + k] = f2bf(lr * bi + li * br);
    }
    if (tid < 64) { lamL[g * 128 + tid] = lp_re[16 * 64 + tid]; lamL[g * 128 + 64 + tid] = lp_im[16 * 64 + tid]; }
  }
}

DI_ void s5_inu_phase(const bf16_t* HB, const bf16_t* WinT, bf16_t* Uc, bf16_t* smem) {
  TILE_IDS(); CFG_A16();
  for (int t = blockIdx.x; t < 64 * 8; t += gridDim.x) {
    const int mt_ = (t & 7) + 8 * (t >> 6), nt = (t >> 3) & 7;
    GemmArgs g{HB + (size_t)mt_ * 256 * DM, DM, nullptr, 0, 1 << 30, WinT + (size_t)nt * 256 * DM, DM, 16};
    f32x4 acc[MT][NQ];
    gemm_mainloop16<WM, WN, MT, NQ>(g, smem, acc);
    {
      bf16_t* st = smem + w * (128 * LDS_STRIDE);
#pragma unroll
      for (int mt = 0; mt < MT; ++mt)
#pragma unroll
        for (int nq = 0; nq < NQ; ++nq)
#pragma unroll
          for (int j = 0; j < 4; ++j) {
            const int rl = mt * 16 + quad * 4 + j, cl = nq * 16 + r16;
            st[((cl >> 4) * 8 + (rl >> 4)) * 256 + (rl & 15) * 16 + (cl & 15)] = f2bf(acc[mt][nq][j]);
          }
      stage_sync();
      const int g0 = (nt * 256 + wn * 64) >> 4, n0 = (mt_ * 256 + wm * 128) >> 4;
#pragma unroll 4
      for (int it = 0; it < 16; ++it) {
        const int blk = it * 2 + (lane >> 5), gl = blk >> 3, nl = blk & 7;
        const uint4 v = *(const uint4*)(st + blk * 256 + (lane & 31) * 8);
        *(uint4*)(Uc + ((size_t)(g0 + gl) * 1024 + n0 + nl) * 256 + (lane & 31) * 8) = v;
      }
      stage_sync();
    }
  }
}
DI_ void s5_inz_phase(const bf16_t* HB, const bf16_t* WinTz, bf16_t* Z, bf16_t* smem) {
  TILE_IDS(); CFG_A16();
  for (int t = blockIdx.x; t < 64 * 8; t += gridDim.x) {
    const int mt_ = (t & 7) + 8 * (t >> 6), nt = (t >> 3) & 7;
    GemmArgs g{HB + (size_t)mt_ * 256 * DM, DM, nullptr, 0, 1 << 30, WinTz + (size_t)nt * 256 * DM, DM, 16};
    f32x4 acc[MT][NQ];
    gemm_mainloop16<WM, WN, MT, NQ>(g, smem, acc);
    bf16_t* st = wave_stage<128>(smem, w);
#pragma unroll
    for (int mt = 0; mt < MT; ++mt)
#pragma unroll
      for (int nq = 0; nq < NQ; ++nq)
#pragma unroll
        for (int j = 0; j < 4; ++j)
          st[(mt * 16 + quad * 4 + j) * LDS_STRIDE + nq * 16 + r16] = f2bf(siluf_(acc[mt][nq][j]));
    stage_flush<128, 64>(st, Z + (size_t)(mt_ * 256 + wm * 128) * DIN + nt * 256 + wn * 64, DIN, lane);
  }
}
DI_ void s5_sgemm_phase(const bf16_t* Uc, const bf16_t* WgT, const float* lamL, bf16_t* Sx, bf16_t* smem) {
  TILE_IDS(); CFG_B16();
  float* Sl = (float*)smem;
  float* xch = Sl + 256 * 129;
  for (int t = blockIdx.x; t < 128 * 4; t += gridDim.x) {
    const int gi = t >> 2, mt_ = t & 3;
    GemmArgs g{Uc + ((size_t)gi * 1024 + mt_ * 256) * 256, 256, nullptr, 0, 1 << 30, WgT + (size_t)gi * 128 * 256, 256, 4};
    f32x4 acc[MT][NQ];
    gemm_mainloop16<WM, WN, MT, NQ>(g, smem, acc);
#pragma unroll
    for (int mt = 0; mt < MT; ++mt)
#pragma unroll
      for (int nq = 0; nq < NQ; ++nq)
#pragma unroll
        for (int j = 0; j < 4; ++j)
          Sl[(wm * 64 + mt * 16 + quad * 4 + j) * 129 + wn * 64 + nq * 16 + r16] = acc[mt][nq][j];
    __syncthreads();
    {
      const int pp = tid & 63, seg = tid >> 6;
      const float lr = lamL[gi * 128 + pp], li = lamL[gi * 128 + 64 + pp];
      const float* sp = Sl + (seg * 32) * 129 + pp;
      float xr = 0.f, xi = 0.f;
#pragma unroll 8
      for (int c = 0; c < 32; ++c) { const float sr = sp[c * 129], si = sp[c * 129 + 64]; const float tt = lr * xr - li * xi + sr; xi = lr * xi + li * xr + si; xr = tt; }
      xch[seg * 128 + pp] = xr; xch[seg * 128 + 64 + pp] = xi;
      __syncthreads();
      float ar = lr, ai = li;
#pragma unroll
      for (int q = 0; q < 5; ++q) { const float tt = ar * ar - ai * ai; ai = 2.f * ar * ai; ar = tt; }
      xr = 0.f; xi = 0.f;
      for (int s2 = 0; s2 < seg; ++s2) { const float tt = ar * xr - ai * xi + xch[s2 * 128 + pp]; xi = ar * xi + ai * xr + xch[s2 * 128 + 64 + pp]; xr = tt; }
      bf16_t* base = Sx + ((size_t)(mt_ * 256 + seg * 32) * 128 + gi) * 128 + pp;
#pragma unroll 8
      for (int c = 0; c < 32; ++c) {
        base[(size_t)c * 16384] = f2bf(xr); base[(size_t)c * 16384 + 64] = f2bf(xi);
        const float sr = sp[c * 129], si = sp[c * 129 + 64];
        const float tt = lr * xr - li * xi + sr; xi = lr * xi + li * xr + si; xr = tt;
      }
    }
  }
}
DI_ void s5_scan_phase(bf16_t* Sx, const float* lamL, float* sm) {
  int tid_ = threadIdx.x; asm volatile("" : "+v"(tid_)); const int tid = tid_;
  const int pp = tid & 63, seg = tid >> 6;
  for (int item = blockIdx.x; item < 512; item += gridDim.x) {
    const int b = item >> 7, g = item & 127;
    const float lr = lamL[g * 128 + pp], li = lamL[g * 128 + 64 + pp];
    bf16_t* base = Sx + ((size_t)(b * 256 + seg * 32) * 128 + g) * 128 + pp;
    float xr = 0.f, xi = 0.f;
    for (int c0 = 0; c0 < 32; c0 += 8) {
      float sr[8], si[8];
#pragma unroll
      for (int c = 0; c < 8; ++c) { sr[c] = bf2f(base[(size_t)(c0 + c) * 16384]); si[c] = bf2f(base[(size_t)(c0 + c) * 16384 + 64]); }
#pragma unroll
      for (int c = 0; c < 8; ++c) { const float t = lr * xr - li * xi + sr[c]; xi = lr * xi + li * xr + si[c]; xr = t; }
    }
    __syncthreads();
    sm[seg * 128 + pp] = xr; sm[seg * 128 + 64 + pp] = xi;
    __syncthreads();
    float ar = lr, ai = li;
#pragma unroll
    for (int q = 0; q < 5; ++q) { const float t = ar * ar - ai * ai; ai = 2.f * ar * ai; ar = t; }
    xr = 0.f; xi = 0.f;
    for (int s2 = 0; s2 < seg; ++s2) { const float t = ar * xr - ai * xi + sm[s2 * 128 + pp]; xi = ar * xi + ai * xr + sm[s2 * 128 + 64 + pp]; xr = t; }
    for (int c0 = 0; c0 < 32; c0 += 8) {
      float sr[8], si[8];
#pragma unroll
      for (int c = 0; c < 8; ++c) { sr[c] = bf2f(base[(size_t)(c0 + c) * 16384]); si[c] = bf2f(base[(size_t)(c0 + c) * 16384 + 64]); }
#pragma unroll
      for (int c = 0; c < 8; ++c) {
        base[(size_t)(c0 + c) * 16384] = f2bf(xr); base[(size_t)(c0 + c) * 16384 + 64] = f2bf(xi);
        const float t = lr * xr - li * xi + sr[c]; xi = lr * xi + li * xr + si[c]; xr = t;
      }
    }
  }
}
DI_ void s5_ygemm_phase(const bf16_t* Uc, const bf16_t* Sx, const bf16_t* YgT, bf16_t* Y, bf16_t* smem) {
  TILE_IDS(); CFG_A16();
  for (int t = blockIdx.x; t < 128 * 4; t += gridDim.x) {
    const int xq = t & 7, kq = t >> 3;
    const int gi = xq * 16 + (kq >> 2), mt_ = kq & 3;
    GemmArgs g{Uc + ((size_t)gi * 1024 + mt_ * 256) * 256, 256, Sx + ((size_t)mt_ * 256 * 128 + gi) * 128, 16384, 4,
               YgT + (size_t)gi * 256 * 384, 384, 6};
    f32x4 acc[MT][NQ];
    gemm_mainloop16<WM, WN, MT, NQ>(g, smem, acc);
#pragma unroll
    for (int mt = 0; mt < MT; ++mt)
#pragma unroll
      for (int nq = 0; nq < NQ; ++nq)
#pragma unroll
        for (int j = 0; j < 4; ++j) {
          const int row = mt_ * 256 + wm * 128 + mt * 16 + quad * 4 + j;
          Y[((size_t)row * 16 + wn * 4 + nq) * DIN + gi * 16 + r16] = f2bf(geluf_(acc[mt][nq][j]));
        }
  }
}
DI_ void s5_glu_phase(const bf16_t* HB, const bf16_t* WinTz, const bf16_t* Y, const bf16_t* WgluT, const float* b_glu, bf16_t* Z, bf16_t* smem) {
  TILE_IDS(); CFG_A16();
  for (int t = blockIdx.x; t < 64 * 8; t += gridDim.x) {
    const int mt_ = (t & 7) + 8 * (t >> 6), nt = (t >> 3) & 7;
    f32x4 acc[MT][NQ];
    {
      GemmArgs gz{HB + (size_t)mt_ * 256 * DM, DM, nullptr, 0, 1 << 30, WinTz + (size_t)nt * 256 * DM, DM, 16};
      gemm_mainloop16<WM, WN, MT, NQ>(gz, smem, acc);
      bf16_t* stz = wave_stage<128>(smem, w);
#pragma unroll
      for (int mt = 0; mt < MT; ++mt)
#pragma unroll
        for (int nq = 0; nq < NQ; ++nq)
#pragma unroll
          for (int j = 0; j < 4; ++j)
            stz[(mt * 16 + quad * 4 + j) * LDS_STRIDE + nq * 16 + r16] = f2bf(siluf_(acc[mt][nq][j]));
      stage_flush<128, 64>(stz, Z + (size_t)(mt_ * 256 + wm * 128) * DIN + nt * 256 + wn * 64, DIN, lane);
    }
    GemmArgs g{Y + (size_t)mt_ * 256 * DIN, DIN, nullptr, 0, 1 << 30, WgluT + (size_t)nt * 256 * DIN, DIN, 32};
    gemm_mainloop16<WM, WN, MT, NQ>(g, smem, acc);
    {
      bf16_t* stY = smem + w * (128 * LDS_STRIDE);
      bf16_t* stZ = stY + 64 * LDS_STRIDE;
      const float* bgp = b_glu + nt * 256 + wn * 64 + r16;
      const float bg0 = bgp[0], bg1 = bgp[16], bg2 = bgp[32], bg3 = bgp[48];
#pragma unroll
      for (int h2 = 0; h2 < 2; ++h2) {
        const size_t off = (size_t)(mt_ * 256 + wm * 128 + h2 * 64) * DIN + nt * 256 + wn * 64;
        stage_load<64, 64>(stY, Y + off, DIN, lane);
        stage_load<64, 64>(stZ, Z + off, DIN, lane);
#pragma unroll
        for (int m2 = 0; m2 < 4; ++m2)
#pragma unroll
          for (int nq = 0; nq < NQ; ++nq)
#pragma unroll
            for (int j = 0; j < 4; ++j) {
              const int idx = (m2 * 16 + quad * 4 + j) * LDS_STRIDE + nq * 16 + r16;
              const float yv = bf2f(stY[idx]);
              stZ[idx] = f2bf(yv * sigmoidf_(acc[h2 * 4 + m2][nq][j] + (nq == 0 ? bg0 : nq == 1 ? bg1 : nq == 2 ? bg2 : bg3)) * bf2f(stZ[idx]));
            }
        stage_flush<64, 64>(stZ, Z + off, DIN, lane);
      }
    }
  }
}

DI_ void mla_wq_phase(const float* w_uq, const float* w_ukv, const float* gq, const float* gkv, bf16_t* WqT, float* sm) {
  int tid_ = threadIdx.x; asm volatile("" : "+v"(tid_)); const int tid = tid_;
  float* As = sm;
  float* Bs = sm + 32 * 129;
  float* Os = Bs + 128 * 129;
  for (int item = blockIdx.x; item < 16 * 12; item += gridDim.x) {
    const int h = item / 12, c0 = (item % 12) * 32;
    __syncthreads();
#pragma unroll
    for (int q = 0; q < 2; ++q) {
      const int e = tid + q * NT, ci = e >> 5, d4 = e & 31;
      const float4 v = *(const float4*)(w_uq + (size_t)(c0 + ci) * 3072 + h * 192 + d4 * 4);
      float* p_ = As + ci * 129 + d4 * 4; p_[0] = v.x; p_[1] = v.y; p_[2] = v.z; p_[3] = v.w;
    }
#pragma unroll
    for (int q = 0; q < 8; ++q) {
      const int e = tid + q * NT, rr = e >> 5, d4 = e & 31;
      const float4 v = *(const float4*)(w_ukv + (size_t)rr * 4096 + h * 256 + d4 * 4);
      float* p_ = Bs + rr * 129 + d4 * 4; p_[0] = v.x; p_[1] = v.y; p_[2] = v.z; p_[3] = v.w;
    }
    __syncthreads();
    {
      const int rr = tid & 127, cg = tid >> 7;
      float acc[8];
#pragma unroll
      for (int j = 0; j < 8; ++j) acc[j] = 0.f;
      for (int d = 0; d < 128; ++d) {
        const float bv = Bs[rr * 129 + d];
#pragma unroll
        for (int j = 0; j < 8; ++j) acc[j] += As[(cg + 4 * j) * 129 + d] * bv;
      }
      const float gk = gkv[rr];
#pragma unroll
      for (int j = 0; j < 8; ++j) Os[rr * 33 + cg + 4 * j] = acc[j] * gk * gq[c0 + cg + 4 * j];
    }
    __syncthreads();
#pragma unroll
    for (int q = 0; q < 8; ++q) {
      const int e = tid + q * NT, rr = e >> 5, ci = e & 31;
      WqT[(size_t)(h * 192 + rr) * 384 + c0 + ci] = f2bf(Os[rr * 33 + ci]);
    }
  }
  for (int idx = blockIdx.x * NT + tid; idx < 16 * 64 * 384; idx += gridDim.x * NT) {
    const int c = idx % 384, nn = idx / 384, h = nn >> 6, j = nn & 63, n = h * 192 + 128 + j;
    WqT[(size_t)n * 384 + c] = f2bf(w_uq[(size_t)c * 3072 + n] * gq[c]);
  }
}
DI_ void rope_table_phase(const int* pos, float* cosT, float* sinT) {
  for (int idx = blockIdx.x * NT + threadIdx.x; idx < T_TOK * 32; idx += gridDim.x * NT) {
    const float ang = (float)pos[idx >> 5] * INVF[idx & 31];
    float sn, cs; sincos_red(ang, &sn, &cs);
    cosT[idx] = cs; sinT[idx] = sn;
  }
}
DI_ void mla_in_phase(const bf16_t* HB, const bf16_t* WinT, bf16_t* cq, float* qssq, float* ckv, bf16_t* Kc, bf16_t* Z,
                      const float* cosT, const float* sinT, bf16_t* smem) {
  TILE_IDS(); CFG_A16();
  for (int t = blockIdx.x; t < 64 * 11; t += gridDim.x) {
    const int mt_ = (t & 7) + 8 * (t / 88), nt = (t >> 3) % 11;
    GemmArgs g{HB + (size_t)mt_ * 256 * DM, DM, nullptr, 0, 1 << 30, WinT + (size_t)nt * 256 * DM, DM, 16};
    f32x4 acc[MT][NQ];
    gemm_mainloop16<WM, WN, MT, NQ>(g, smem, acc);
    const int rbase = mt_ * 256 + wm * 128;
    const int cb = nt * 4 + wn;
    bf16_t* st = wave_stage<128>(smem, w);
    if (cb < 6) {
#pragma unroll
      for (int mt = 0; mt < MT; ++mt)
#pragma unroll
        for (int nq = 0; nq < NQ; ++nq)
#pragma unroll
          for (int j = 0; j < 4; ++j)
            st[(mt * 16 + quad * 4 + j) * LDS_STRIDE + nq * 16 + r16] = f2bf(acc[mt][nq][j]);
      stage_rowstats<128>(st, lane, [&](int row, float s1, float s2) { (void)s1; qssq[(size_t)(rbase + row) * 8 + cb] = s2; });
      stage_flush<128, 64>(st, cq + (size_t)rbase * 384 + cb * 64, 384, lane);
    } else if (cb < 8) {
#pragma unroll
      for (int mt = 0; mt < MT; ++mt)
#pragma unroll
        for (int nq = 0; nq < NQ; ++nq)
#pragma unroll
          for (int j = 0; j < 4; ++j)
            ckv[(size_t)(rbase + mt * 16 + quad * 4 + j) * 128 + (cb - 6) * 64 + nq * 16 + r16] = acc[mt][nq][j];
    } else if (cb == 8) {
#pragma unroll
      for (int mt = 0; mt < MT; ++mt) {
#pragma unroll
        for (int nq = 0; nq < 2; ++nq)
#pragma unroll
          for (int j = 0; j < 4; ++j) {
            const int row = rbase + mt * 16 + quad * 4 + j, jj = nq * 16 + r16;
            const float cs = cosT[(size_t)row * 32 + jj], sn = sinT[(size_t)row * 32 + jj];
            const float x1 = acc[mt][nq][j], x2 = acc[mt][nq + 2][j];
            Kc[(size_t)row * 192 + 128 + jj] = f2bf(x1 * cs - x2 * sn);
            Kc[(size_t)row * 192 + 160 + jj] = f2bf(x2 * cs + x1 * sn);
          }
        asm volatile("" ::: "memory");
      }
    } else if (cb >= 10 && cb < 42) {
#pragma unroll
      for (int mt = 0; mt < MT; ++mt)
#pragma unroll
        for (int nq = 0; nq < NQ; ++nq)
#pragma unroll
          for (int j = 0; j < 4; ++j)
            st[(mt * 16 + quad * 4 + j) * LDS_STRIDE + nq * 16 + r16] = f2bf(siluf_(acc[mt][nq][j]));
      stage_flush<128, 64>(st, Z + (size_t)rbase * DIN + (cb - 10) * 64, DIN, lane);
    }
  }
}
DI_ void mla_q_phase(const bf16_t* cq, const float* qssq, const bf16_t* WqT, bf16_t* Qp, const float* cosT, const float* sinT,
                     const float* ckv, bf16_t* Kc, bf16_t* KcT, bf16_t* smem) {
  TILE_IDS(); CFG_A16();
  const float QSC = 0.07216878364870322f * 1.4426950408889634f;
  float* fsc = (float*)((unsigned char*)smem + SMEM_MAIN);
  for (int t = blockIdx.x; t < 64 * 12; t += gridDim.x) {
    const int mt_ = (t & 7) + 8 * (t / 96), nt = (t >> 3) % 12;
    GemmArgs g{cq + (size_t)mt_ * 256 * 384, 384, nullptr, 0, 1 << 30, WqT + (size_t)nt * 256 * 384, 384, 6};
    f32x4 acc[MT][NQ];
    __syncthreads();
    if (tid < 256) {
      const float* ps = qssq + (size_t)(mt_ * 256 + tid) * 8;
      const float ss = ps[0] + ps[1] + ps[2] + ps[3] + ps[4] + ps[5];
      fsc[tid] = rsqrtf(ss * (1.f / 384.f) + 1e-6f) * QSC;
    }
    gemm_mainloop16s<WM, WN, MT, NQ>(g, smem, acc);
    const int cb = nt * 4 + wn;
    const bool is_rope = (cb % 3) == 2;
    const int colb = cb * 64;
    bf16_t* st = wave_stage<128>(smem, w);
#pragma unroll
    for (int mt = 0; mt < MT; ++mt) {
#pragma unroll
      for (int nq = 0; nq < 2; ++nq)
#pragma unroll
        for (int j = 0; j < 4; ++j) {
          const int rl = mt * 16 + quad * 4 + j, jj = nq * 16 + r16;
          const float f = fsc[wm * 128 + rl];
          float x1 = acc[mt][nq][j] * f, x2 = acc[mt][nq + 2][j] * f;
          if (is_rope) {
            const int row = mt_ * 256 + wm * 128 + rl;
            const float cs = cosT[(size_t)row * 32 + jj], sn = sinT[(size_t)row * 32 + jj];
            const float y1 = x1 * cs - x2 * sn, y2 = x2 * cs + x1 * sn;
            x1 = y1; x2 = y2;
          }
          st[rl * LDS_STRIDE + jj] = f2bf(x1);
          st[rl * LDS_STRIDE + 32 + jj] = f2bf(x2);
        }
      asm volatile("" ::: "memory");
      __builtin_amdgcn_sched_barrier(0);
    }
    stage_flush<128, 64>(st, Qp + (size_t)(mt_ * 256 + wm * 128) * 3072 + colb, 3072, lane);
  }
  float* tl = (float*)smem;
  float* rs = tl + 64 * 129;
  for (int item = blockIdx.x; item < T_TOK / 64; item += gridDim.x) {
    const int t0 = item * 64;
    __syncthreads();
    for (int e = tid; e < 64 * 128; e += NT) tl[(e >> 7) * 129 + (e & 127)] = ckv[(size_t)t0 * 128 + e];
    __syncthreads();
    {
      const int tok = tid >> 3, part = tid & 7;
      float ss = 0.f;
      for (int j = 0; j < 16; ++j) { const float v = tl[tok * 129 + part * 16 + j]; ss += v * v; }
      ss += __shfl_xor(ss, 1); ss += __shfl_xor(ss, 2); ss += __shfl_xor(ss, 4);
      if (part == 0) rs[tok] = rsqrtf(ss * (1.f / 128.f) + 1e-6f);
    }
    __syncthreads();
    for (int e = tid; e < 64 * 128; e += NT) {
      const int tok = e >> 7, rr = e & 127;
      Kc[(size_t)(t0 + tok) * 192 + rr] = f2bf(tl[tok * 129 + rr] * rs[tok]);
    }
    const int b = t0 >> 12, l0 = t0 & 4095;
    for (int e = tid; e < 64 * 128; e += NT) {
      const int rr = e >> 6, tok = e & 63;
      KcT[((size_t)b * 128 + rr) * SEQ + l0 + tok] = f2bf(tl[tok * 129 + rr] * rs[tok]);
    }
  }
}

constexpr int KT = 64;
constexpr int NSUB = KT / 32;
constexpr int KS_STRIDE = 200;
constexpr int VS_STRIDE = KT + 4;
DI_ void mla_attn_phase(const bf16_t* Qp, const bf16_t* Kc, const bf16_t* KcT, const bf16_t* WuvT, bf16_t* Z, bf16_t* smem) {
  TILE_IDS();
  bf16_t* Ks = smem;
  bf16_t* Vs = smem + KT * KS_STRIDE;
  bf16_t* Ws = smem + 36864;
  const int G = gridDim.x;
  for (int round = 0;; ++round) {
    const int slot = (round & 1) ? (G - 1 - (int)blockIdx.x) : (int)blockIdx.x;
    const int item = round * G + slot;
    if (item >= 1024) break;
    const int qb = 15 - (item >> 6), bh = item & 63, b = bh >> 4, h = bh & 15;
    const int q0 = qb * 256, qw0 = q0 + w * 32, qrow = qw0 + r;
    const size_t tok = (size_t)b * SEQ + qrow;
    bf16x8 qf[12];
    {
      const bf16_t* qptr = Qp + tok * 3072 + h * 192 + hf * 8;
#pragma unroll
      for (int ks = 0; ks < 12; ++ks) qf[ks] = *(const bf16x8*)(qptr + ks * 16);
    }
    {
      const bf16_t* wsrc = WuvT + (size_t)h * 128 * 128;
#pragma unroll
      for (int i = 0; i < 4; ++i) {
        const int row = i * 32 + (tid >> 4), slot = tid & 15;
        __builtin_amdgcn_global_load_lds((const unsigned*)(wsrc + row * 128 + ((slot ^ (row & 15)) * 8)), (unsigned*)(Ws + (i * NT + tid) * 8), 16, 0, 0);
      }
    }
    f32x16 O[4];
#pragma unroll
    for (int dt = 0; dt < 4; ++dt)
#pragma unroll
      for (int i = 0; i < 16; ++i) O[dt][i] = 0.f;
    float m = -1e30f, ls = 0.f;
    const int ntile = (q0 + 256) / KT;
    const bf16_t* Kg = Kc + (size_t)b * SEQ * 192;
    const bf16_t* Vg = KcT + (size_t)b * 128 * SEQ;
    const int kc0 = tid, kc1 = tid + 512, kc2 = tid + 1024;
    const int kr0 = kc0 / 24, kr1 = kc1 / 24, kr2 = kc2 / 24;
    const int ko0 = kr0 * 192 + (kc0 - kr0 * 24) * 8, ko1 = kr1 * 192 + (kc1 - kr1 * 24) * 8, ko2 = kr2 * 192 + (kc2 - kr2 * 24) * 8;
    const int kl0 = kr0 * KS_STRIDE + (kc0 - kr0 * 24) * 8, kl1 = kr1 * KS_STRIDE + (kc1 - kr1 * 24) * 8, kl2 = kr2 * KS_STRIDE + (kc2 - kr2 * 24) * 8;
    const int vr0 = tid >> 3, vr1 = (tid + 512) >> 3, vcc = (tid & 7) * 8;
    uint4 rk0 = *(const uint4*)(Kg + ko0), rk1 = *(const uint4*)(Kg + ko1), rk2 = *(const uint4*)(Kg + ko2);
    uint4 rv0 = *(const uint4*)(Vg + (size_t)vr0 * SEQ + vcc), rv1 = *(const uint4*)(Vg + (size_t)vr1 * SEQ + vcc);
    for (int kt = 0; kt < ntile; ++kt) {
      __syncthreads();
      *(uint4*)(Ks + kl0) = rk0; *(uint4*)(Ks + kl1) = rk1; *(uint4*)(Ks + kl2) = rk2;
      { uint2 lo, hi; lo.x = rv0.x; lo.y = rv0.y; hi.x = rv0.z; hi.y = rv0.w;
        *(uint2*)(Vs + vr0 * VS_STRIDE + vcc) = lo; *(uint2*)(Vs + vr0 * VS_STRIDE + vcc + 4) = hi; }
      { uint2 lo, hi; lo.x = rv1.x; lo.y = rv1.y; hi.x = rv1.z; hi.y = rv1.w;
        *(uint2*)(Vs + vr1 * VS_STRIDE + vcc) = lo; *(uint2*)(Vs + vr1 * VS_STRIDE + vcc + 4) = hi; }
      __syncthreads();
      if (kt + 1 < ntile) {
        const int k1 = (kt + 1) * KT;
        const bf16_t* Kn = Kg + (size_t)k1 * 192;
        rk0 = *(const uint4*)(Kn + ko0); rk1 = *(const uint4*)(Kn + ko1); rk2 = *(const uint4*)(Kn + ko2);
        rv0 = *(const uint4*)(Vg + (size_t)vr0 * SEQ + k1 + vcc); rv1 = *(const uint4*)(Vg + (size_t)vr1 * SEQ + k1 + vcc);
      }
      const int k0 = kt * KT;
      if (k0 <= qw0 + 31) {
        f32x16 st[NSUB];
#pragma unroll
        for (int sub = 0; sub < NSUB; ++sub) {
#pragma unroll
          for (int i = 0; i < 16; ++i) st[sub][i] = 0.f;
#pragma unroll
          for (int ks = 0; ks < 12; ++ks) {
            bf16x8 a = *(const bf16x8*)(Ks + (sub * 32 + r) * KS_STRIDE + ks * 16 + hf * 8);
            st[sub] = MFMA32(a, qf[ks], st[sub]);
            if ((ks & 3) == 3) __builtin_amdgcn_sched_barrier(0);
          }
        }
        if (k0 + KT - 1 > qw0) {
#pragma unroll
          for (int sub = 0; sub < NSUB; ++sub)
#pragma unroll
            for (int i = 0; i < 16; ++i)
              if (k0 + sub * 32 + crow(i, hf) > qrow) st[sub][i] = -1e30f;
        }
        float mx = -1e30f;
#pragma unroll
        for (int sub = 0; sub < NSUB; ++sub)
#pragma unroll
          for (int i = 0; i < 16; ++i) mx = fmaxf(mx, st[sub][i]);
        mx = fmaxf(mx, __shfl_xor(mx, 32));
        if (!__all(mx - m <= 8.f)) {
          const float mn = fmaxf(m, mx);
          const float alpha = __builtin_amdgcn_exp2f(m - mn);
          m = mn;
          ls *= alpha;
#pragma unroll
          for (int dt = 0; dt < 4; ++dt)
#pragma unroll
            for (int i = 0; i < 16; ++i) O[dt][i] *= alpha;
        }
        float psum = 0.f;
#pragma unroll
        for (int sub = 0; sub < NSUB; ++sub)
#pragma unroll
          for (int i = 0; i < 16; ++i) { const float pv = __builtin_amdgcn_exp2f(st[sub][i] - m); st[sub][i] = pv; psum += pv; }
        ls += psum;
#pragma unroll
        for (int sub = 0; sub < NSUB; ++sub)
#pragma unroll
          for (int s2 = 0; s2 < 2; ++s2) {
            u32x4 pfu;
#pragma unroll
            for (int j = 0; j < 4; ++j) pfu[j] = pack2(st[sub][8 * s2 + 2 * j], st[sub][8 * s2 + 2 * j + 1]);
            const bf16x8 pf = __builtin_bit_cast(bf16x8, pfu);
#pragma unroll
            for (int dt = 0; dt < 4; ++dt) {
              const bf16_t* vp = Vs + (dt * 32 + r) * VS_STRIDE + sub * 32 + s2 * 16 + hf * 4;
              const uint2 vlo = *(const uint2*)vp;
              const uint2 vhi = *(const uint2*)(vp + 8);
              u32x4 vau; vau[0] = vlo.x; vau[1] = vlo.y; vau[2] = vhi.x; vau[3] = vhi.y;
              O[dt] = MFMA32(__builtin_bit_cast(bf16x8, vau), pf, O[dt]);
            }
          }
      }
    }
    const float lt = ls + __shfl_xor(ls, 32);
    const float inv = 1.f / lt;
    f32x16 U[4];
#pragma unroll
    for (int dq = 0; dq < 4; ++dq)
#pragma unroll
      for (int i = 0; i < 16; ++i) U[dq][i] = 0.f;
#pragma unroll
    for (int dt = 0; dt < 4; ++dt)
#pragma unroll
      for (int s2 = 0; s2 < 2; ++s2) {
        u32x4 ofu;
#pragma unroll
        for (int j = 0; j < 4; ++j) ofu[j] = pack2(O[dt][8 * s2 + 2 * j] * inv, O[dt][8 * s2 + 2 * j + 1] * inv);
        const bf16x8 of = __builtin_bit_cast(bf16x8, ofu);
        const int dv0 = dt * 32 + s2 * 16 + hf * 4;
        const int c0 = dv0 >> 3, hb = (dv0 & 7);
#pragma unroll
        for (int dq = 0; dq < 4; ++dq) {
          const int R = dq * 32 + r;
          const uint2 wlo = *(const uint2*)(Ws + R * 128 + ((c0 ^ (R & 15)) * 8) + hb);
          const uint2 whi = *(const uint2*)(Ws + R * 128 + (((c0 + 1) ^ (R & 15)) * 8) + hb);
          u32x4 wau; wau[0] = wlo.x; wau[1] = wlo.y; wau[2] = whi.x; wau[3] = whi.y;
          U[dq] = MFMA32(__builtin_bit_cast(bf16x8, wau), of, U[dq]);
        }
      }
    __syncthreads();
    {
      bf16_t* so = smem + w * (32 * 136);
#pragma unroll
      for (int dq = 0; dq < 4; ++dq)
#pragma unroll
        for (int i4 = 0; i4 < 4; ++i4) {
          uint2 o;
          o.x = pack2(U[dq][i4 * 4 + 0], U[dq][i4 * 4 + 1]);
          o.y = pack2(U[dq][i4 * 4 + 2], U[dq][i4 * 4 + 3]);
          *(uint2*)(so + r * 136 + dq * 32 + i4 * 8 + hf * 4) = o;
        }
      stage_sync();
      bf16_t* zb = Z + ((size_t)b * SEQ + qw0) * DIN + h * 128;
#pragma unroll 4
      for (int it = 0; it < 8; ++it) {
        const int row = it * 4 + (lane >> 4), ch = lane & 15;
        const uint4 uv = *(const uint4*)(so + row * 136 + ch * 8);
        bf16_t* pz = zb + (size_t)row * DIN + ch * 8;
        const uint4 zv = *(const uint4*)pz;
        const unsigned uu[4] = {uv.x, uv.y, uv.z, uv.w}, zz[4] = {zv.x, zv.y, zv.z, zv.w};
        unsigned oo[4];
#pragma unroll
        for (int j = 0; j < 4; ++j)
          oo[j] = pack2(__uint_as_float(uu[j] << 16) * __uint_as_float(zz[j] << 16), __uint_as_float(uu[j] & 0xffff0000u) * __uint_as_float(zz[j] & 0xffff0000u));
        uint4 ov; ov.x = oo[0]; ov.y = oo[1]; ov.z = oo[2]; ov.w = oo[3];
        *(uint4*)pz = ov;
      }
    }
    __syncthreads();
  }
}
DI_ void mla_uv_phase(const bf16_t* Qp, const bf16_t* WuvT, bf16_t* Z, bf16_t* smem) {
  TILE_IDS(); CFG_B();
  for (int t = blockIdx.x; t < 64 * 16; t += gridDim.x) {
    const int mt = t >> 4, h = t & 15;
    GemmArgs g{Qp + (size_t)mt * 256 * 3072 + h * 192, 3072, nullptr, 0, 1 << 30, WuvT + (size_t)h * 128 * 128, 128, 2};
    f32x16 acc[MI][NI];
    gemm_mainloop<WM, WN, MI, NI>(g, smem, acc);
    {
      bf16_t* st = wave_stage<64>(smem, w);
      bf16_t* gp = Z + (size_t)(mt * 256 + wm * 64) * DIN + h * 128 + wn * 64;
      stage_load<64, 64>(st, gp, DIN, lane);
#pragma unroll
      for (int mi = 0; mi < MI; ++mi)
#pragma unroll
        for (int ni = 0; ni < NI; ++ni)
#pragma unroll
          for (int i = 0; i < 16; ++i) {
            bf16_t* pz = st + (mi * 32 + crow(i, hf)) * LDS_STRIDE + ni * 32 + r;
            *pz = f2bf(acc[mi][ni][i] * bf2f(*pz));
          }
      stage_flush<64, 64>(st, gp, DIN, lane);
    }
  }
}

#define XB_TMO      128
#define XB_XCNT(j)  (256  + 64 * (j))
#define XB_XSUB(j)  (1280 + 64 * (j))
#define XB_XGEN(j)  (2304 + 64 * (j))
#define XB_TOP      3328
#define XB_TOPGEN   3392
#define XCD_BAR_WORDS 3456
#define XB_SPIN_CAP (1u << 18)
#define LAS __attribute__((address_space(3)))
DI_ unsigned xb_ld(unsigned* p)              { return __hip_atomic_load(p, __ATOMIC_RELAXED, __HIP_MEMORY_SCOPE_AGENT); }
DI_ unsigned xb_add(unsigned* p, unsigned v) { return __hip_atomic_fetch_add(p, v, __ATOMIC_RELAXED, __HIP_MEMORY_SCOPE_AGENT); }
DI_ unsigned xb_xcc_id() { return (unsigned)__builtin_amdgcn_s_getreg((3 << 11) | 20) & 0xFu; }
#define XB_SPIN(cond, bar) do { unsigned _sp = 0; while (cond) { __builtin_amdgcn_s_sleep(1); \
    if ((++_sp & 255u) == 0u) { if (xb_ld(&(bar)[XB_TMO])) break; if (_sp > XB_SPIN_CAP) { atomicAdd(&(bar)[XB_TMO], 1u); break; } } } } while (0)
struct XcdBarrier { unsigned* bar; unsigned x; volatile LAS unsigned* st; };
DI_ XcdBarrier xcd_barrier_post(unsigned* bar, volatile LAS unsigned* st) {
  XcdBarrier b; b.bar = bar; b.x = xb_xcc_id(); b.st = st;
  if (threadIdx.x == 0) (void)xb_add(&bar[XB_XCNT(b.x)], 1u);
  return b;
}
DI_ void xcd_barrier_complete(unsigned* bar, unsigned x, unsigned& nloc, unsigned& nx) {
  const unsigned G = gridDim.x * gridDim.y * gridDim.z;
  unsigned sum, cnt, mine, sp = 0u;
  for (;;) {
    sum = 0u; cnt = 0u; mine = 0u;
#pragma unroll
    for (unsigned j = 0; j < 16; ++j) { const unsigned c = xb_ld(&bar[XB_XCNT(j)]); sum += c; cnt += (c > 0u) ? 1u : 0u; mine = (j == x) ? c : mine; }
    if (sum == G) break;
    __builtin_amdgcn_s_sleep(1);
    if ((++sp & 255u) == 0u) { if (xb_ld(&bar[XB_TMO])) break; if (sp > XB_SPIN_CAP) { atomicAdd(&bar[XB_TMO], 1u); break; } }
  }
  nloc = mine > 0u ? mine : 1u; nx = cnt > 0u ? cnt : 1u;
}
DI_ void xcd_barrier(const XcdBarrier& b) {
  asm volatile("s_waitcnt vmcnt(0)" ::: "memory");
  __syncthreads();
  if (threadIdx.x == 0) {
    unsigned* bar = b.bar;
    __builtin_amdgcn_s_waitcnt(0);
    unsigned nloc = b.st[0], nx = b.st[1];
    if (nloc == 0u) { xcd_barrier_complete(bar, b.x, nloc, nx); b.st[0] = nloc; b.st[1] = nx; }
    const unsigned old = xb_add(&bar[XB_XSUB(b.x)], 1u);
    const unsigned gen = old / nloc;
    if (old + 1u == (gen + 1u) * nloc) {
      __builtin_amdgcn_fence(__ATOMIC_RELEASE, "agent");
      asm volatile("s_waitcnt vmcnt(0)" ::: "memory");
      const unsigned og = xb_add(&bar[XB_TOP], 1u);
      const unsigned tg = og / nx;
      if (og + 1u == (tg + 1u) * nx) xb_add(&bar[XB_TOPGEN], 1u);
      else XB_SPIN(xb_ld(&bar[XB_TOPGEN]) == tg, bar);
      __builtin_amdgcn_fence(__ATOMIC_ACQUIRE, "agent");
      xb_add(&bar[XB_XGEN(b.x)], 1u);
      asm volatile("s_waitcnt vmcnt(0)" ::: "memory");
    } else {
      XB_SPIN(xb_ld(&bar[XB_XGEN(b.x)]) == gen, bar);
      __builtin_amdgcn_fence(__ATOMIC_ACQUIRE, "agent");
      asm volatile("s_waitcnt vmcnt(0)" ::: "memory");
    }
  }
  __syncthreads();
}

constexpr int NPHASE = 23;

DI_ void gmlp_pre(const Params& p, int base, const float* hsrc, bf16_t* smem) {
  unsigned char* ws = p.ws;
  convT_phase<MAP_GMLP>(p.in[base + 1], 1024, 6144, 6144, p.in[base + 0], (bf16_t*)(ws + W_OFF), (float*)smem);
  convT_phase<MAP_IDENT>(p.in[base + 6], 2048, 1024, 1024, nullptr, (bf16_t*)(ws + W_OFF + 12 * MiB), (float*)smem);
  rownorm_phase(hsrc, (bf16_t*)(ws + HB_OFF));
}

__global__ void __launch_bounds__(512, 2) mega_kernel(Params p, int ph_lo, int ph_hi) {
  extern __shared__ __attribute__((aligned(16))) unsigned char smem_raw[];
  bf16_t* smem = (bf16_t*)smem_raw;
  cg::grid_group grid = cg::this_grid();
  volatile LAS unsigned* xbst = (volatile LAS unsigned*)(smem_raw + SMEM_MAIN + 2048);
  if (threadIdx.x == 0) { xbst[0] = 0u; xbst[1] = 0u; }
  __syncthreads();
  XcdBarrier xb = xcd_barrier_post((unsigned*)(p.ws + BAR_OFF), xbst);
  if (ph_lo < 0) grid.sync();
#define WSP(T, off) ((T*)(p.ws + (size_t)(off)))
#define HB WSP(bf16_t, HB_OFF)
#define B1 WSP(bf16_t, B1_OFF)
#define B2 WSP(bf16_t, B2_OFF)
#define B3 WSP(bf16_t, B3_OFF)
#define gWin WSP(bf16_t, W_OFF)
#define gWout WSP(bf16_t, W_OFF + 12 * MiB)
#define sWin WSP(bf16_t, W_OFF)
#define sWg WSP(bf16_t, 8 * MiB)
#define sYg WSP(bf16_t, 16 * MiB)
#define sWglu WSP(bf16_t, 40 * MiB)
#define sWout WSP(bf16_t, 48 * MiB)
#define sLam WSP(float, 52 * MiB)
#define mWin WSP(bf16_t, W_OFF)
#define mWq WSP(bf16_t, 6 * MiB)
#define mWuv WSP(bf16_t, 9 * MiB)
#define mWout WSP(bf16_t, 10 * MiB)
#define mCq WSP(bf16_t, 14 * MiB)
#define mCkv WSP(float, 26 * MiB)
#define mKc WSP(bf16_t, 34 * MiB)
#define mKcT WSP(bf16_t, 40 * MiB)
#define mQssq WSP(float, 44 * MiB)
#define mCos WSP(float, 45 * MiB)
#define mSin WSP(float, 47 * MiB)
#define mQp B1
#define mZ WSP(bf16_t, 192 * MiB)
#define h (p.out)

#ifndef ONLY
#define ONLY -1
#endif
#ifndef OLO
#define OLO 0
#define OHI 99
#endif
#ifndef EXCL
#define EXCL -1
#endif
#define PH(n) if ((ONLY < 0 || ONLY == n) && (n >= OLO && n <= OHI) && n != EXCL && ph_lo <= n && n < ph_hi)
#define SY(n) if (ph_lo <= n && n + 1 < ph_hi) xcd_barrier(xb);
  PH(0) {
    gmlp_pre(p, 2, p.in[0], smem);
  }
  SY(0)
  PH(1) {
    gmlp_in_phase(HB, gWin, B1, B2, (float*)B3, smem);
  }
  SY(1)
  PH(2) {
    gmlp_gate_phase(p.in[6], p.in[7], p.in[4], p.in[5], B2, (const float*)B3, B1, smem);
  }
  SY(2)
  PH(3) {
    out_phase(B1, gWout, p.in[0], h, smem);
  }
  SY(3)
  PH(4) {
    convT_phase<MAP_IDENT>(p.in[10], 1024, 4096, 4096, p.in[9], sWin, (float*)smem);
        convT_phase<MAP_IDENT>(p.in[19], 2048, 2048, 2048, nullptr, sWglu, (float*)smem);
        convT_phase<MAP_IDENT>(p.in[21], 2048, 1024, 1024, nullptr, sWout, (float*)smem);
        ssm_pre_phase(p, (float*)smem, sWg, sYg, sLam);
        rownorm_phase(h, HB);
  }
  SY(4)
  PH(5) {
    s5_inu_phase(HB, sWin, B1, smem);
  }
  SY(5)
  PH(6) {
    s5_sgemm_phase(B1, sWg, sLam, B3, smem);
  }
  SY(6)
  PH(8) {
    s5_ygemm_phase(B1, B3, sYg, B2, smem);
  }
  SY(8)
  PH(10) {
    s5_glu_phase(HB, sWin + (size_t)2048 * DM, B2, sWglu, p.in[20], B1, smem);
  }
  SY(10)
  PH(11) {
    out_phase(B1, sWout, h, h, smem);
  }
  SY(11)
  PH(12) {
    convT_phase<MAP_MLA>(p.in[23], 1024, 2624, 2816, p.in[22], mWin, (float*)smem);
        convT_phase<MAP_UV>(p.in[27], 128, 4096, 2048, p.in[26], mWuv, (float*)smem);
        convT_phase<MAP_IDENT>(p.in[28], 2048, 1024, 1024, nullptr, mWout, (float*)smem);
        mla_wq_phase(p.in[25], p.in[27], p.in[24], p.in[26], mWq, (float*)smem);
        rope_table_phase((const int*)p.in[1], mCos, mSin);
        rownorm_phase(h, HB);
  }
  SY(12)
  PH(13) {
    mla_in_phase(HB, mWin, mCq, mQssq, mCkv, mKc, mZ, mCos, mSin, smem);
  }
  SY(13)
  PH(14) {
    mla_q_phase(mCq, mQssq, mWq, mQp, mCos, mSin, mCkv, mKc, mKcT, smem);
  }
  SY(14)
  PH(15) {
    mla_attn_phase(mQp, mKc, mKcT, mWuv, mZ, smem);
  }
  SY(15)
  PH(17) {
    out_phase(mZ, mWout, h, h, smem);
  }
  SY(17)
  PH(18) {
    gmlp_pre(p, 29, h, smem);
  }
  SY(18)
  PH(19) {
    gmlp_in_phase(HB, gWin, B1, B2, (float*)B3, smem);
  }
  SY(19)
  PH(20) {
    gmlp_gate_phase(p.in[33], p.in[34], p.in[31], p.in[32], B2, (const float*)B3, B1, smem);
  }
  SY(20)
  PH(21) {
    out_phase(B1, gWout, h, h, smem);
  }
  SY(21)
  PH(22) {
    finalnorm_phase(h, p.in[36]);
  }
  SY(22)
}

extern "C" void kernel_launch(void* const* d_in, const int* in_sizes, int n_in, void* d_out, int out_size, void* d_ws, size_t ws_size,
                              hipStream_t stream) {
  static int grid_blocks = 0;
  if (!grid_blocks) {
    int dev = 0, cus = 0, per_cu = 0;
    hipGetDevice(&dev);
    hipDeviceGetAttribute(&cus, hipDeviceAttributeMultiprocessorCount, dev);
    hipFuncSetAttribute((const void*)mega_kernel, hipFuncAttributeMaxDynamicSharedMemorySize, SMEM_BYTES);
    hipOccupancyMaxActiveBlocksPerMultiprocessor(&per_cu, (const void*)mega_kernel, NT, SMEM_BYTES);
    if (per_cu > 1) per_cu = 1;
    if (per_cu < 1) per_cu = 1;
    grid_blocks = cus * per_cu;
  }
  Params p{};
  for (int i = 0; i < 37 && i < n_in; ++i) p.in[i] = (const float*)d_in[i];
  p.out = (float*)d_out;
  p.ws = (unsigned char*)d_ws;
  hipMemsetAsync((unsigned char*)d_ws + BAR_OFF, 0, XCD_BAR_WORDS * 4, stream);
  int lo = 0, hi = NPHASE;
  void* args[] = {&p, &lo, &hi};
  hipError_t e = hipLaunchCooperativeKernel((const void*)mega_kernel, dim3(grid_blocks), dim3(NT), args, SMEM_BYTES, stream);
  if (e != hipSuccess) fprintf(stderr, "cooperative launch failed: %s (grid %d)\n", hipGetErrorString(e), grid_blocks);
}
```

```cpp
#include <hip/hip_runtime.h>
#include <hip/hip_cooperative_groups.h>
#include <stdint.h>
#include <stdio.h>
namespace cg = cooperative_groups;

typedef unsigned short bf16_t;
typedef __attribute__((ext_vector_type(8))) short bf16x8;
typedef __attribute__((ext_vector_type(16))) float f32x16;
typedef __attribute__((ext_vector_type(4))) unsigned u32x4;

#define DI_ __device__ __forceinline__
#define MFMA32(a, b, c) __builtin_amdgcn_mfma_f32_32x32x16_bf16((a), (b), (c), 0, 0, 0)

constexpr int T_TOK = 16384;
constexpr int DM = 1024;
constexpr int DIN = 2048;
constexpr int SEQ = 4096;
constexpr int LDS_STRIDE = 72;
constexpr int TILE_E = 128 * LDS_STRIDE;
constexpr int NT = 512;
constexpr int SMEM_MAIN = 2 * 512 * LDS_STRIDE * 2;
constexpr int SMEM_BYTES = SMEM_MAIN + 2048 + 16;
constexpr size_t BAR_OFF = 62ull << 20;
constexpr size_t MiB = 1ull << 20;

constexpr size_t W_OFF = 0, HB_OFF = 64 * MiB, B1_OFF = 96 * MiB, B2_OFF = 160 * MiB, B3_OFF = 224 * MiB;

struct Params {
  const float* in[37];
  float* out;
  unsigned char* ws;
};

__device__ const float INVF[32] = {
  1.000000000e+00f, 7.498942614e-01f, 5.623413324e-01f, 4.216965139e-01f, 3.162277639e-01f, 2.371373773e-01f, 1.778279394e-01f, 1.333521307e-01f,
  1.000000015e-01f, 7.498941571e-02f, 5.623413250e-02f, 4.216965288e-02f, 3.162277490e-02f, 2.371373773e-02f, 1.778279431e-02f, 1.333521493e-02f,
  9.999999776e-03f, 7.498941850e-03f, 5.623413250e-03f, 4.216964822e-03f, 3.162277630e-03f, 2.371373586e-03f, 1.778279431e-03f, 1.333521446e-03f,
  1.000000047e-03f, 7.498942432e-04f, 5.623413017e-04f, 4.216965172e-04f, 3.162277571e-04f, 2.371373703e-04f, 1.778279402e-04f, 1.333521504e-04f};

typedef float f32x2 __attribute__((ext_vector_type(2)));
typedef __bf16 bf16x2_t __attribute__((ext_vector_type(2)));
DI_ unsigned short f2bf(float x) { __bf16 h = (__bf16)x; return __builtin_bit_cast(unsigned short, h); }
DI_ float bf2f(unsigned short b) { return __uint_as_float(((unsigned)b) << 16); }
DI_ unsigned pack2(float a, float b) { f32x2 v; v[0] = a; v[1] = b; return __builtin_bit_cast(unsigned, __builtin_convertvector(v, bf16x2_t)); }
DI_ float sigmoidf_(float x) { return __builtin_amdgcn_rcpf(1.f + __expf(-x)); }
DI_ float siluf_(float x) { return x * sigmoidf_(x); }
DI_ float geluf_(float x) { float y = 1.5957691216057308f * (x + 0.044715f * x * x * x); return x * sigmoidf_(y); }
DI_ int crow(int i, int hf) { return (i & 3) + 8 * (i >> 2) + 4 * hf; }
DI_ float red32(float v) { v += __shfl_xor(v, 1); v += __shfl_xor(v, 2); v += __shfl_xor(v, 4); v += __shfl_xor(v, 8); v += __shfl_xor(v, 16); return v; }
DI_ float red64(float v) { v = red32(v); v += __shfl_xor(v, 32); return v; }
DI_ void sincos_red(float x, float* s, float* c) {
  double xd = (double)x;
  double k = rint(xd * 0.15915494309189535);
  float r = (float)(xd - k * 6.283185307179586);
  *s = __sinf(r); *c = __cosf(r);
}

struct GemmArgs {
  const bf16_t* A1; int lda1;
  const bf16_t* A2; int lda2; int kt_split;
  const bf16_t* Bt; int ldb; int nkt;
};

template <int WM, int WN, int MI, int NI>
DI_ void gemm_compute_sw(const bf16_t* As, const bf16_t* Bs, int wm, int wn, int r, int hf, f32x16 (&acc)[MI][NI]) {
  bf16x8 a[2][MI], b[2][NI];
  int ao[MI], ax[MI], bo[NI], bx[NI];
#pragma unroll
  for (int mi = 0; mi < MI; ++mi) { const int R = wm * MI * 32 + mi * 32 + r; ao[mi] = R * 64; ax[mi] = (R >> 1) & 7; }
#pragma unroll
  for (int ni = 0; ni < NI; ++ni) { const int R = wn * NI * 32 + ni * 32 + r; bo[ni] = R * 64; bx[ni] = (R >> 1) & 7; }
#pragma unroll
  for (int mi = 0; mi < MI; ++mi) a[0][mi] = *(const bf16x8*)(As + ao[mi] + ((hf ^ ax[mi]) * 8));
#pragma unroll
  for (int ni = 0; ni < NI; ++ni) b[0][ni] = *(const bf16x8*)(Bs + bo[ni] + ((hf ^ bx[ni]) * 8));
#pragma unroll
  for (int ks = 0; ks < 4; ++ks) {
    if (ks < 3) {
#pragma unroll
      for (int mi = 0; mi < MI; ++mi) a[(ks + 1) & 1][mi] = *(const bf16x8*)(As + ao[mi] + ((((ks + 1) * 2 + hf) ^ ax[mi]) * 8));
#pragma unroll
      for (int ni = 0; ni < NI; ++ni) b[(ks + 1) & 1][ni] = *(const bf16x8*)(Bs + bo[ni] + ((((ks + 1) * 2 + hf) ^ bx[ni]) * 8));
    }
#pragma unroll
    for (int mi = 0; mi < MI; ++mi)
#pragma unroll
      for (int ni = 0; ni < NI; ++ni) acc[mi][ni] = MFMA32(a[ks & 1][mi], b[ks & 1][ni], acc[mi][ni]);
    __builtin_amdgcn_sched_barrier(0);
  }
}

template <int WM, int WN, int MI, int NI>
DI_ void gemm_compute(const bf16_t* As, const bf16_t* Bs, int wm, int wn, int r, int hf, f32x16 (&acc)[MI][NI]) {
#pragma unroll
  for (int ks = 0; ks < 4; ++ks) {
    bf16x8 a[MI], b[NI];
#pragma unroll
    for (int mi = 0; mi < MI; ++mi) a[mi] = *(const bf16x8*)(As + (wm * MI * 32 + mi * 32 + r) * LDS_STRIDE + ks * 16 + hf * 8);
#pragma unroll
    for (int ni = 0; ni < NI; ++ni) b[ni] = *(const bf16x8*)(Bs + (wn * NI * 32 + ni * 32 + r) * LDS_STRIDE + ks * 16 + hf * 8);
#pragma unroll
    for (int mi = 0; mi < MI; ++mi)
#pragma unroll
      for (int ni = 0; ni < NI; ++ni) acc[mi][ni] = MFMA32(a[mi], b[ni], acc[mi][ni]);
  }
}

template <int WM, int WN, int MI, int NI, bool ZERO = true>
DI_ void gemm_mainloop(const GemmArgs& g, bf16_t* smem, f32x16 (&acc)[MI][NI]) {
  constexpr int BM = WM * MI * 32, BN = WN * NI * 32;
  constexpr int ATILE = BM * 64, STAGE = (BM + BN) * 64;
  constexpr int ACH = BM / 64, BCH = BN / 64, NPC = ACH + BCH, PPK = (NPC + 1) / 2;
  int tid_ = threadIdx.x; asm volatile("" : "+v"(tid_));
  const int tid = tid_, lane = tid & 63, w = tid >> 6, wm = w / WN, wn = w % WN;
  const int r = lane & 31, hf = lane >> 5;
  const int lrow = tid >> 3;
  const int gc = ((tid & 7) ^ ((lrow >> 1) & 7)) * 8;
  if (ZERO) {
#pragma unroll
    for (int mi = 0; mi < MI; ++mi)
#pragma unroll
      for (int ni = 0; ni < NI; ++ni)
#pragma unroll
        for (int i = 0; i < 16; ++i) acc[mi][ni][i] = 0.f;
  }
  const int key = (r >> 1) & 7;
  const int abase = (wm * MI * 32 + r) * 64, bbase = ATILE + (wn * NI * 32 + r) * 64;
  const int koff0 = ((0 + hf) ^ key) * 8, koff1 = ((2 + hf) ^ key) * 8, koff2 = ((4 + hf) ^ key) * 8, koff3 = ((6 + hf) ^ key) * 8;
  __syncthreads();
  {
    const bf16_t* a; int lda;
    if (0 < g.kt_split) { a = g.A1; lda = g.lda1; } else { a = g.A2; lda = g.lda2; }
    const int toffa = lrow * lda + gc, toffb = lrow * g.ldb + gc;
#pragma unroll
    for (int i = 0; i < ACH; ++i)
      __builtin_amdgcn_global_load_lds((const unsigned*)(a + (size_t)i * 64 * lda + toffa), (unsigned*)(smem + (i * NT + tid) * 8), 16, 0, 0);
#pragma unroll
    for (int i = 0; i < BCH; ++i)
      __builtin_amdgcn_global_load_lds((const unsigned*)(g.Bt + (size_t)i * 64 * g.ldb + toffb), (unsigned*)(smem + ATILE + (i * NT + tid) * 8), 16, 0, 0);
  }
  __syncthreads();
  bf16x8 a[2][MI], b[2][NI];
#pragma unroll
  for (int mi = 0; mi < MI; ++mi) a[0][mi] = *(const bf16x8*)(smem + abase + mi * 2048 + koff0);
#pragma unroll
  for (int ni = 0; ni < NI; ++ni) b[0][ni] = *(const bf16x8*)(smem + bbase + ni * 2048 + koff0);
  for (int kt = 0; kt < g.nkt; ++kt) {
    const bool more = (kt + 1 < g.nkt);
    const int k1 = kt + 1;
    const bf16_t* an; int ldan;
    if (k1 < g.kt_split) { an = g.A1 + k1 * 64; ldan = g.lda1; } else { an = g.A2 + (k1 - g.kt_split) * 64; ldan = g.lda2; }
    const bf16_t* bn = g.Bt + k1 * 64;
    const int toffa = lrow * ldan + gc, toffb = lrow * g.ldb + gc;
    bf16_t* Sn = smem + (k1 & 1) * STAGE;
    const bf16_t* Sc = smem + (kt & 1) * STAGE;
#pragma unroll
    for (int ks = 0; ks < 4; ++ks) {
      if (more) {
#pragma unroll
        for (int q = 0; q < PPK; ++q) {
          const int j = ks * PPK + q;
          if (j < ACH)
            __builtin_amdgcn_global_load_lds((const unsigned*)(an + (size_t)j * 64 * ldan + toffa), (unsigned*)(Sn + (j * NT + tid) * 8), 16, 0, 0);
          else if (j < NPC)
            __builtin_amdgcn_global_load_lds((const unsigned*)(bn + (size_t)(j - ACH) * 64 * g.ldb + toffb), (unsigned*)(Sn + ATILE + ((j - ACH) * NT + tid) * 8), 16, 0, 0);
        }
      }
      if (ks < 3) {
        const int ko = (ks == 0) ? koff1 : (ks == 1) ? koff2 : koff3;
#pragma unroll
        for (int mi = 0; mi < MI; ++mi) a[(ks + 1) & 1][mi] = *(const bf16x8*)(Sc + abase + mi * 2048 + ko);
#pragma unroll
        for (int ni = 0; ni < NI; ++ni) b[(ks + 1) & 1][ni] = *(const bf16x8*)(Sc + bbase + ni * 2048 + ko);
      } else {
        __syncthreads();
        if (more) {
#pragma unroll
          for (int mi = 0; mi < MI; ++mi) a[0][mi] = *(const bf16x8*)(Sn + abase + mi * 2048 + koff0);
#pragma unroll
          for (int ni = 0; ni < NI; ++ni) b[0][ni] = *(const bf16x8*)(Sn + bbase + ni * 2048 + koff0);
        }
      }
      __builtin_amdgcn_sched_barrier(0);
#pragma unroll
      for (int mi = 0; mi < MI; ++mi)
#pragma unroll
        for (int ni = 0; ni < NI; ++ni) acc[mi][ni] = MFMA32(a[ks & 1][mi], b[ks & 1][ni], acc[mi][ni]);
      __builtin_amdgcn_sched_barrier(0);
    }
  }
}

typedef __attribute__((ext_vector_type(4))) float f32x4;
#define MFMA16(a, b, c) __builtin_amdgcn_mfma_f32_16x16x32_bf16((a), (b), (c), 0, 0, 0)
template <int WM, int WN, int MT, int NQ>
DI_ void gemm_mainloop16(const GemmArgs& gr, bf16_t* smem, f32x4 (&acc)[MT][NQ]) {
  struct { const bf16_t* A1; int lda1; const bf16_t* A2; int lda2; int kt_split; const bf16_t* Bt; int ldb; int nkt; } g;
  g.A1 = gr.A1; g.lda1 = gr.lda1; g.A2 = gr.A2 ? gr.A2 : gr.A1; g.lda2 = gr.A2 ? gr.lda2 : gr.lda1; g.kt_split = gr.kt_split; g.Bt = gr.Bt; g.ldb = gr.ldb; g.nkt = gr.nkt;
  constexpr int BM = WM * MT * 16, BN = WN * NQ * 16;
  constexpr int ATILE = BM * 64, STAGE = (BM + BN) * 64;
  constexpr int ACH = BM / 64, BCH = BN / 64, NPC = ACH + BCH, PPK = (NPC + 1) / 2;
  int tid_ = threadIdx.x; asm volatile("" : "+v"(tid_));
  const int tid = tid_, lane = tid & 63, w = tid >> 6, wm = w / WN, wn = w % WN;
  const int r16 = lane & 15, quad = lane >> 4;
  const int lrow = tid >> 3;
  const int gc = ((tid & 7) ^ ((lrow >> 1) & 7)) * 8;
#pragma unroll
  for (int mt = 0; mt < MT; ++mt)
#pragma unroll
    for (int nq = 0; nq < NQ; ++nq)
#pragma unroll
      for (int j = 0; j < 4; ++j) acc[mt][nq][j] = 0.f;
  const int key = (r16 >> 1) & 7;
  const int abase = (wm * MT * 16 + r16) * 64, bbase = ATILE + (wn * NQ * 16 + r16) * 64;
  const int koff0 = ((0 + quad) ^ key) * 8, koff1 = ((4 + quad) ^ key) * 8;
  __syncthreads();
  {
    const bf16_t* a0 = (0 < g.kt_split) ? g.A1 : g.A2;
    const int lda0 = (0 < g.kt_split) ? g.lda1 : g.lda2;
    const int toffa = lrow * lda0 + gc, toffb = lrow * g.ldb + gc;
#pragma unroll
    for (int i = 0; i < ACH; ++i)
      __builtin_amdgcn_global_load_lds((const unsigned*)(a0 + (size_t)i * 64 * lda0 + toffa), (unsigned*)(smem + (i * NT + tid) * 8), 16, 0, 0);
#pragma unroll
    for (int i = 0; i < BCH; ++i)
      __builtin_amdgcn_global_load_lds((const unsigned*)(g.Bt + (size_t)i * 64 * g.ldb + toffb), (unsigned*)(smem + ATILE + (i * NT + tid) * 8), 16, 0, 0);
  }
  __syncthreads();
#pragma unroll 1
  for (int kt = 0; kt < g.nkt; ++kt) {
    const bool more = (kt + 1 < g.nkt);
    const int k1 = kt + 1;
    const bool first = k1 < g.kt_split;
    const bf16_t* an = (first ? g.A1 : g.A2) + (first ? k1 : k1 - g.kt_split) * 64;
    const int ldan = first ? g.lda1 : g.lda2;
    const bf16_t* bn = g.Bt + k1 * 64;
    const int toffa = lrow * ldan + gc, toffb = lrow * g.ldb + gc;
    bf16_t* Sn = smem + (k1 & 1) * STAGE;
    const bf16_t* Sc = smem + (kt & 1) * STAGE;
    __builtin_amdgcn_iglp_opt(0);
#pragma unroll
    for (int ks = 0; ks < 2; ++ks) {
      if (more) {
#pragma unroll
        for (int q = 0; q < PPK; ++q) {
          const int j = ks * PPK + q;
          if (j < ACH)
            __builtin_amdgcn_global_load_lds((const unsigned*)(an + (size_t)j * 64 * ldan + toffa), (unsigned*)(Sn + (j * NT + tid) * 8), 16, 0, 0);
          else if (j < NPC)
            __builtin_amdgcn_global_load_lds((const unsigned*)(bn + (size_t)(j - ACH) * 64 * g.ldb + toffb), (unsigned*)(Sn + ATILE + ((j - ACH) * NT + tid) * 8), 16, 0, 0);
        }
      }
      const int ko = ks ? koff1 : koff0;
      bf16x8 a[MT], b[NQ];
#pragma unroll
      for (int mt = 0; mt < MT; ++mt) a[mt] = *(const bf16x8*)(Sc + abase + mt * 1024 + ko);
#pragma unroll
      for (int nq = 0; nq < NQ; ++nq) b[nq] = *(const bf16x8*)(Sc + bbase + nq * 1024 + ko);
#pragma unroll
      for (int mt = 0; mt < MT; ++mt)
#pragma unroll
        for (int nq = 0; nq < NQ; ++nq) acc[mt][nq] = MFMA16(a[mt], b[nq], acc[mt][nq]);
    }
    __syncthreads();
  }
}

template <int WM, int WN, int MT, int NQ>
DI_ void gemm_mainloop16s(const GemmArgs& gr, bf16_t* smem, f32x4 (&acc)[MT][NQ]) {
  struct { const bf16_t* A1; int lda1; const bf16_t* A2; int lda2; int kt_split; const bf16_t* Bt; int ldb; int nkt; } g;
  g.A1 = gr.A1; g.lda1 = gr.lda1; g.A2 = gr.A2 ? gr.A2 : gr.A1; g.lda2 = gr.A2 ? gr.lda2 : gr.lda1; g.kt_split = gr.kt_split; g.Bt = gr.Bt; g.ldb = gr.ldb; g.nkt = gr.nkt;
  constexpr int BM = WM * MT * 16, BN = WN * NQ * 16;
  constexpr int ATILE = BM * 64, STAGE = (BM + BN) * 64;
  constexpr int ACH = BM / 64, BCH = BN / 64, NPC = ACH + BCH, PPK = (NPC + 1) / 2;
  int tid_ = threadIdx.x; asm volatile("" : "+v"(tid_));
  const int tid = tid_, lane = tid & 63, w = tid >> 6, wm = w / WN, wn = w % WN;
  const int r16 = lane & 15, quad = lane >> 4;
  const int lrow = tid >> 3;
  const int gc = ((tid & 7) ^ ((lrow >> 1) & 7)) * 8;
#pragma unroll
  for (int mt = 0; mt < MT; ++mt)
#pragma unroll
    for (int nq = 0; nq < NQ; ++nq)
#pragma unroll
      for (int j = 0; j < 4; ++j) acc[mt][nq][j] = 0.f;
  const int key = (r16 >> 1) & 7;
  const int abase = (wm * MT * 16 + r16) * 64, bbase = ATILE + (wn * NQ * 16 + r16) * 64;
  const int koff0 = ((0 + quad) ^ key) * 8, koff1 = ((4 + quad) ^ key) * 8;
  __syncthreads();
  {
    const bf16_t* a0 = (0 < g.kt_split) ? g.A1 : g.A2;
    const int lda0 = (0 < g.kt_split) ? g.lda1 : g.lda2;
    const int toffa = lrow * lda0 + gc, toffb = lrow * g.ldb + gc;
#pragma unroll
    for (int i = 0; i < ACH; ++i)
      __builtin_amdgcn_global_load_lds((const unsigned*)(a0 + (size_t)i * 64 * lda0 + toffa), (unsigned*)(smem + (i * NT + tid) * 8), 16, 0, 0);
#pragma unroll
    for (int i = 0; i < BCH; ++i)
      __builtin_amdgcn_global_load_lds((const unsigned*)(g.Bt + (size_t)i * 64 * g.ldb + toffb), (unsigned*)(smem + ATILE + (i * NT + tid) * 8), 16, 0, 0);
  }
  __syncthreads();
#pragma unroll 1
  for (int kt = 0; kt < g.nkt; ++kt) {
    const bool more = (kt + 1 < g.nkt);
    const int k1 = kt + 1;
    const bool first = k1 < g.kt_split;
    const bf16_t* an = (first ? g.A1 : g.A2) + (first ? k1 : k1 - g.kt_split) * 64;
    const int ldan = first ? g.lda1 : g.lda2;
    const bf16_t* bn = g.Bt + k1 * 64;
    const int toffa = lrow * ldan + gc, toffb = lrow * g.ldb + gc;
    bf16_t* Sn = smem + (k1 & 1) * STAGE;
    const bf16_t* Sc = smem + (kt & 1) * STAGE;
#pragma unroll
    for (int ks = 0; ks < 2; ++ks) {
      if (more) {
#pragma unroll
        for (int q = 0; q < PPK; ++q) {
          const int j = ks * PPK + q;
          if (j < ACH)
            __builtin_amdgcn_global_load_lds((const unsigned*)(an + (size_t)j * 64 * ldan + toffa), (unsigned*)(Sn + (j * NT + tid) * 8), 16, 0, 0);
          else if (j < NPC)
            __builtin_amdgcn_global_load_lds((const unsigned*)(bn + (size_t)(j - ACH) * 64 * g.ldb + toffb), (unsigned*)(Sn + ATILE + ((j - ACH) * NT + tid) * 8), 16, 0, 0);
        }
      }
      const int ko = ks ? koff1 : koff0;
      bf16x8 a[MT], b[NQ];
#pragma unroll
      for (int mt = 0; mt < MT; ++mt) a[mt] = *(const bf16x8*)(Sc + abase + mt * 1024 + ko);
#pragma unroll
      for (int nq = 0; nq < NQ; ++nq) b[nq] = *(const bf16x8*)(Sc + bbase + nq * 1024 + ko);
#pragma unroll
      for (int mt = 0; mt < MT; ++mt)
#pragma unroll
        for (int nq = 0; nq < NQ; ++nq) acc[mt][nq] = MFMA16(a[mt], b[nq], acc[mt][nq]);
      __builtin_amdgcn_sched_barrier(0);
    }
    __syncthreads();
  }
}

template <int ROWS> DI_ bf16_t* wave_stage(bf16_t* smem, int w) { return smem + w * ROWS * LDS_STRIDE; }
DI_ void stage_sync() { asm volatile("s_waitcnt lgkmcnt(0)" ::: "memory"); __builtin_amdgcn_wave_barrier(); }
template <int ROWS, int COLS> DI_ void stage_flush(const bf16_t* st, bf16_t* out, size_t ld, int lane) {
  constexpr int CPR = COLS / 8, RPI = 64 / CPR;
  stage_sync();
#pragma unroll 4
  for (int it = 0; it < ROWS / RPI; ++it) {
    const int row = it * RPI + lane / CPR, ch = lane % CPR;
    const uint4 v = *(const uint4*)(st + row * LDS_STRIDE + ch * 8);
    *(uint4*)(out + (size_t)row * ld + ch * 8) = v;
  }
  stage_sync();
}

template <int ROWS, int COLS> DI_ void stage_load(bf16_t* st, const bf16_t* in, size_t ld, int lane) {
  constexpr int CPR = COLS / 8, RPI = 64 / CPR;
#pragma unroll 4
  for (int it = 0; it < ROWS / RPI; ++it) {
    const int row = it * RPI + lane / CPR, ch = lane % CPR;
    const uint4 v = *(const uint4*)(in + (size_t)row * ld + ch * 8);
    *(uint4*)(st + row * LDS_STRIDE + ch * 8) = v;
  }
  stage_sync();
}
template <int ROWS, class F> DI_ void stage_rowstats(const bf16_t* st, int lane, F f) {
  stage_sync();
#pragma unroll 2
  for (int it = 0; it < ROWS / 8; ++it) {
    const int row = it * 8 + (lane >> 3), ch = lane & 7;
    const uint4 v = *(const uint4*)(st + row * LDS_STRIDE + ch * 8);
    const unsigned u[4] = {v.x, v.y, v.z, v.w};
    float s1 = 0.f, s2 = 0.f;
#pragma unroll
    for (int j = 0; j < 4; ++j) {
      const float a = __uint_as_float(u[j] << 16), b = __uint_as_float(u[j] & 0xffff0000u);
      s1 += a + b; s2 += a * a + b * b;
    }
    s1 += __shfl_xor(s1, 1); s2 += __shfl_xor(s2, 1);
    s1 += __shfl_xor(s1, 2); s2 += __shfl_xor(s2, 2);
    s1 += __shfl_xor(s1, 4); s2 += __shfl_xor(s2, 4);
    if (ch == 0) f(row, s1, s2);
  }
}

#define TILE_IDS() int tid_ = threadIdx.x; asm volatile("" : "+v"(tid_)); const int tid = tid_, lane = tid & 63, w = tid >> 6, r = lane & 31, hf = lane >> 5; (void)tid; (void)w; (void)r; (void)hf;
#define CFG_A() constexpr int WM = 2, WN = 4, MI = 4, NI = 2; const int wm = w / WN, wn = w % WN; (void)wm; (void)wn;
#define CFG_B() constexpr int WM = 4, WN = 2, MI = 2, NI = 2; const int wm = w / WN, wn = w % WN; (void)wm; (void)wn;
#define CFG_A16() constexpr int WM = 2, WN = 4, MT = 8, NQ = 4; const int wm = w / WN, wn = w % WN, r16 = lane & 15, quad = lane >> 4; (void)wm; (void)wn; (void)r16; (void)quad;
#define CFG_B16() constexpr int WM = 4, WN = 2, MT = 4, NQ = 4; const int wm = w / WN, wn = w % WN, r16 = lane & 15, quad = lane >> 4; (void)wm; (void)wn; (void)r16; (void)quad;
#define CFG_C() constexpr int WM = 2, WN = 4, MI = 2, NI = 2; const int wm = w / WN, wn = w % WN; (void)wm; (void)wn;

DI_ int norm_row_map(int rr) {
  return (gridDim.x == 256) ? ((((rr >> 3) & 7) + 8 * (rr >> 11)) << 8) + (((rr >> 6) & 31) << 3) + (rr & 7) : rr;
}
DI_ void rownorm_phase(const float* src, bf16_t* dst) {
  const int lane = threadIdx.x & 63;
  const int gw = blockIdx.x * 8 + (threadIdx.x >> 6), nw = gridDim.x * 8;
  for (int rr0 = gw; rr0 < T_TOK; rr0 += 4 * nw) {
    int row[4]; bool ok[4]; float4 v[4][4]; float ss[4];
#pragma unroll
    for (int k = 0; k < 4; ++k) { const int rr = rr0 + k * nw; ok[k] = rr < T_TOK; row[k] = norm_row_map(ok[k] ? rr : rr0); }
#pragma unroll
    for (int k = 0; k < 4; ++k) {
      const float4* s4 = (const float4*)(src + (size_t)row[k] * DM);
#pragma unroll
      for (int i = 0; i < 4; ++i) v[k][i] = s4[lane + i * 64];
    }
#pragma unroll
    for (int k = 0; k < 4; ++k) {
      float a_ = 0.f;
#pragma unroll
      for (int i = 0; i < 4; ++i) a_ += v[k][i].x * v[k][i].x + v[k][i].y * v[k][i].y + v[k][i].z * v[k][i].z + v[k][i].w * v[k][i].w;
      ss[k] = a_;
    }
#pragma unroll
    for (int k = 0; k < 4; ++k) ss[k] = red64(ss[k]);
#pragma unroll
    for (int k = 0; k < 4; ++k) {
      if (ok[k]) {
        const float rs = rsqrtf(ss[k] * (1.f / 1024.f) + 1e-6f);
#pragma unroll
        for (int i = 0; i < 4; ++i) {
          uint2 o; o.x = pack2(v[k][i].x * rs, v[k][i].y * rs); o.y = pack2(v[k][i].z * rs, v[k][i].w * rs);
          *(uint2*)(dst + (size_t)row[k] * DM + (lane + i * 64) * 4) = o;
        }
      }
    }
  }
}

DI_ void finalnorm_phase(float* h, const float* gain) {
  const int lane = threadIdx.x & 63;
  const int gw = blockIdx.x * 8 + (threadIdx.x >> 6), nw = gridDim.x * 8;
  const float4* g4 = (const float4*)gain;
  float4 gv[4];
#pragma unroll
  for (int i = 0; i < 4; ++i) gv[i] = g4[lane + i * 64];
  for (int rr0 = gw; rr0 < T_TOK; rr0 += 4 * nw) {
    int row[4]; bool ok[4]; float4 v[4][4]; float ss[4];
#pragma unroll
    for (int k = 0; k < 4; ++k) { const int rr = rr0 + k * nw; ok[k] = rr < T_TOK; row[k] = norm_row_map(ok[k] ? rr : rr0); }
#pragma unroll
    for (int k = 0; k < 4; ++k) {
      const float4* s4 = (const float4*)(h + (size_t)row[k] * DM);
#pragma unroll
      for (int i = 0; i < 4; ++i) v[k][i] = s4[lane + i * 64];
    }
#pragma unroll
    for (int k = 0; k < 4; ++k) {
      float a_ = 0.f;
#pragma unroll
      for (int i = 0; i < 4; ++i) a_ += v[k][i].x * v[k][i].x + v[k][i].y * v[k][i].y + v[k][i].z * v[k][i].z + v[k][i].w * v[k][i].w;
      ss[k] = a_;
    }
#pragma unroll
    for (int k = 0; k < 4; ++k) ss[k] = red64(ss[k]);
#pragma unroll
    for (int k = 0; k < 4; ++k) {
      if (ok[k]) {
        const float rs = rsqrtf(ss[k] * (1.f / 1024.f) + 1e-6f);
        float4* o4 = (float4*)(h + (size_t)row[k] * DM);
#pragma unroll
        for (int i = 0; i < 4; ++i) {
          float4 o; o.x = v[k][i].x * rs * gv[i].x; o.y = v[k][i].y * rs * gv[i].y; o.z = v[k][i].z * rs * gv[i].z; o.w = v[k][i].w * rs * gv[i].w;
          o4[lane + i * 64] = o;
        }
      }
    }
  }
}

enum { MAP_IDENT = 0, MAP_GMLP = 1, MAP_MLA = 2, MAP_UV = 3 };
template <int MAP> DI_ int colmap(int n) {
  if (MAP == MAP_IDENT) return n;
  if (MAP == MAP_GMLP) {
    if (n < 4096) { int wt = n >> 6, rr = n & 63; int ch = wt * 32 + (rr & 31); return (rr < 32) ? ch : 4096 + ch; }
    return 2048 + (n - 4096);
  }
  if (MAP == MAP_MLA) { if (n < 576) return n; if (n < 640 || n >= 2688) return -1; return n - 64; }
    return (n >> 7) * 256 + 128 + (n & 127);
}
template <int MAP> DI_ void convT_phase(const float* src, int K, int Nsrc, int Ndst, const float* gain, bf16_t* dst, float* tile) {
  const int tx = threadIdx.x & 63, ty = threadIdx.x >> 6;
  const int nkb = K >> 7, ntiles = nkb * (Ndst >> 6);
  for (int t = blockIdx.x; t < ntiles; t += gridDim.x) {
    const int kb = t % nkb, nb = t / nkb, k0 = kb * 128, n0 = nb * 64;
    const int l16 = threadIdx.x & 15, kr = threadIdx.x >> 4;
    const int sc = colmap<MAP>(n0 + 4 * l16);
    __syncthreads();
#pragma unroll
    for (int q = 0; q < 4; ++q) {
      const int kk = kr + q * 32;
      float4 v = (sc >= 0) ? *(const float4*)(src + (size_t)(k0 + kk) * Nsrc + sc) : make_float4(0.f, 0.f, 0.f, 0.f);
      if (gain) { const float gk = gain[k0 + kk]; v.x *= gk; v.y *= gk; v.z *= gk; v.w *= gk; }
      float* tp = tile + kk * 65 + 4 * l16;
      tp[0] = v.x; tp[1] = v.y; tp[2] = v.z; tp[3] = v.w;
    }
    __syncthreads();
#pragma unroll
    for (int q = 0; q < 2; ++q) {
      const int nn = kr + q * 32;
      const float* tp = tile + (8 * l16) * 65 + nn;
      uint4 o;
      o.x = pack2(tp[0], tp[65]); o.y = pack2(tp[2 * 65], tp[3 * 65]); o.z = pack2(tp[4 * 65], tp[5 * 65]); o.w = pack2(tp[6 * 65], tp[7 * 65]);
      *(uint4*)(dst + (size_t)(n0 + nn) * K + k0 + 8 * l16) = o;
    }
  }
}

DI_ void gmlp_in_phase(const bf16_t* HB, const bf16_t* WinT, bf16_t* UZ, bf16_t* VgT, float* vstat, bf16_t* smem) {
  TILE_IDS(); CFG_A16();
  for (int t = blockIdx.x; t < 64 * 24; t += gridDim.x) {
    const int q_ = t >> 3, mt_ = (t & 7) + 8 * (q_ & 7), nt = 4 * (q_ >> 5) + ((q_ >> 3) & 3);
    GemmArgs g{HB + (size_t)mt_ * 256 * DM, DM, nullptr, 0, 1 << 30, WinT + (size_t)nt * 256 * DM, DM, 16};
    f32x4 acc[MT][NQ];
    gemm_mainloop16<WM, WN, MT, NQ>(g, smem, acc);
    const int cb = nt * 4 + wn;
    bf16_t* st = wave_stage<128>(smem, w);
    if (cb < 64) {
#pragma unroll
      for (int mt = 0; mt < MT; ++mt)
#pragma unroll
        for (int nq = 0; nq < 2; ++nq)
#pragma unroll
          for (int j = 0; j < 4; ++j)
            st[(mt * 16 + quad * 4 + j) * LDS_STRIDE + nq * 16 + r16] = f2bf(geluf_(acc[mt][nq][j]) * siluf_(acc[mt][nq + 2][j]));
      stage_flush<128, 32>(st, UZ + (size_t)(mt_ * 256 + wm * 128) * DIN + cb * 32, DIN, lane);
    } else {
      const int cbv = cb - 64;
#pragma unroll
      for (int mt = 0; mt < MT; ++mt)
#pragma unroll
        for (int nq = 0; nq < NQ; ++nq) {
          const int d = cbv * 64 + nq * 16 + r16;
          const float v0 = geluf_(acc[mt][nq][0]), v1 = geluf_(acc[mt][nq][1]), v2 = geluf_(acc[mt][nq][2]), v3 = geluf_(acc[mt][nq][3]);
          uint2 o; o.x = pack2(v0, v1); o.y = pack2(v2, v3);
          *(uint2*)(VgT + ((size_t)(mt_ * 2 + wm) * DIN + d) * 128 + mt * 16 + quad * 4) = o;
          bf16_t* sp = st + (mt * 16 + quad * 4) * LDS_STRIDE + nq * 16 + r16;
          sp[0] = (bf16_t)(o.x & 0xffffu); sp[LDS_STRIDE] = (bf16_t)(o.x >> 16);
          sp[2 * LDS_STRIDE] = (bf16_t)(o.y & 0xffffu); sp[3 * LDS_STRIDE] = (bf16_t)(o.y >> 16);
        }
      const int rowg = mt_ * 256 + wm * 128;
      stage_rowstats<128>(st, lane, [&](int row, float s1, float s2) {
        float2 o; o.x = s1; o.y = s2;
        *(float2*)(vstat + ((size_t)(rowg + row) * 32 + cbv) * 2) = o;
      });
      stage_sync();
    }
  }
}

DI_ void gmlp_gate_phase(const float* w_s, const float* b_s, const float* ln_g, const float* ln_b,
                         const bf16_t* VgT, const float* vstat, bf16_t* UZ, bf16_t* smem) {
  TILE_IDS(); CFG_C();
  constexpr int ATILE = 128 * LDS_STRIDE, STAGE = 384 * LDS_STRIDE;
  float* ext = (float*)((unsigned char*)smem + SMEM_MAIN);
  for (int item = blockIdx.x; item < 1024; item += gridDim.x) {
    const int xk = item >> 3, g = xk & 7, chunk = (((item & 7) + 8 * (xk >> 4)) << 1) + ((xk >> 3) & 1);
    __syncthreads();
    if (tid < 128) {
      const float2* ps = (const float2*)(vstat + (size_t)(chunk * 128 + tid) * 64);
      float s1 = 0.f, s2 = 0.f;
      for (int j = 0; j < 32; ++j) { float2 v = ps[j]; s1 += v.x; s2 += v.y; }
      const float mu = s1 * (1.f / 2048.f);
      const float var = fmaxf(s2 * (1.f / 2048.f) - mu * mu, 0.f);
      ext[tid] = mu; ext[128 + tid] = rsqrtf(var + 1e-6f);
    }
    __syncthreads();
    {
      const int tp = tid >> 2, q = tid & 3;
      const float4* wrow = (const float4*)(w_s + (size_t)(g * 128 + tp) * 128 + q * 32);
      float r0 = 0.f, r1 = 0.f;
#pragma unroll 1
      for (int j8 = 0; j8 < 4; ++j8) {
        const float4 wa = wrow[j8 * 2], wb = wrow[j8 * 2 + 1];
        const float wv[8] = {wa.x, wa.y, wa.z, wa.w, wb.x, wb.y, wb.z, wb.w};
        float sc[8];
#pragma unroll
        for (int j = 0; j < 8; ++j) {
          const int tk = q * 32 + j8 * 8 + j;
          const float wm_ = (tk <= tp) ? wv[j] : 0.f;
          r0 += wm_;
          sc[j] = bf2f(f2bf(wm_ * ext[128 + tk]));
          r1 += sc[j] * ext[tk];
        }
        uint4 o; o.x = pack2(sc[0], sc[1]); o.y = pack2(sc[2], sc[3]); o.z = pack2(sc[4], sc[5]); o.w = pack2(sc[6], sc[7]);
        const int tk0 = q * 32 + j8 * 8;
        *(uint4*)(smem + (tk0 >> 6) * STAGE + tp * LDS_STRIDE + (tk0 & 63)) = o;
      }
      r0 += __shfl_xor(r0, 1); r0 += __shfl_xor(r0, 2);
      r1 += __shfl_xor(r1, 1); r1 += __shfl_xor(r1, 2);
      if (q == 0) { ext[256 + tp] = r0; ext[384 + tp] = r1; }
    }
#pragma unroll 2
    for (int i = 0; i < 8; ++i) {
      const int c = tid + i * NT, d = c >> 4, kc = c & 15;
      uint4 v = *(const uint4*)(VgT + ((size_t)chunk * DIN + g * 256 + d) * 128 + kc * 8);
      *(uint4*)(smem + (kc >> 3) * STAGE + ATILE + d * LDS_STRIDE + (kc & 7) * 8) = v;
    }
    __syncthreads();
    f32x16 acc[MI][NI];
#pragma unroll
    for (int mi = 0; mi < MI; ++mi)
#pragma unroll
      for (int ni = 0; ni < NI; ++ni)
#pragma unroll
        for (int i = 0; i < 16; ++i) acc[mi][ni][i] = 0.f;
    gemm_compute<WM, WN, MI, NI>(smem, smem + ATILE, wm, wn, r, hf, acc);
    gemm_compute<WM, WN, MI, NI>(smem + STAGE, smem + STAGE + ATILE, wm, wn, r, hf, acc);
    __syncthreads();
    {
      bf16_t* st = wave_stage<64>(smem, w);
      bf16_t* gp = UZ + (size_t)(chunk * 128 + wm * 64) * DIN + g * 256 + wn * 64;
      stage_load<64, 64>(st, gp, DIN, lane);
#pragma unroll
      for (int ni = 0; ni < NI; ++ni) {
        const int ch = g * 256 + wn * 64 + ni * 32 + r;
        const float lg = ln_g[ch], lb = ln_b[ch];
#pragma unroll
        for (int mi = 0; mi < MI; ++mi)
#pragma unroll
          for (int i = 0; i < 16; ++i) {
            const int tp = wm * 64 + mi * 32 + crow(i, hf);
            const float sv = lg * (acc[mi][ni][i] - ext[384 + tp]) + lb * ext[256 + tp] + b_s[g * 128 + tp];
            bf16_t* pz = st + (mi * 32 + crow(i, hf)) * LDS_STRIDE + ni * 32 + r;
            *pz = f2bf(bf2f(*pz) * sv);
            if (i == 15) asm volatile("" ::: "memory");
          }
      }
      stage_flush<64, 64>(st, gp, DIN, lane);
    }
  }
}

DI_ void out_phase(const bf16_t* A, const bf16_t* WoutT, const float* hin, float* hout, bf16_t* smem) {
  TILE_IDS();
  constexpr int WM = 2, WN = 4, MT = 8, NQ = 4;
  const int wm = w / WN, wn = w % WN, r16 = lane & 15, quad = lane >> 4;
  for (int t = blockIdx.x; t < 64 * 4; t += gridDim.x) {
    const int mt_ = (t & 7) + 8 * (t >> 5), nt = (t >> 3) & 3;
    GemmArgs g{A + (size_t)mt_ * 256 * DIN, DIN, nullptr, 0, 1 << 30, WoutT + (size_t)nt * 256 * DIN, DIN, 32};
    f32x4 acc[MT][NQ];
    gemm_mainloop16<WM, WN, MT, NQ>(g, smem, acc);
#pragma unroll
    for (int mt = 0; mt < MT; ++mt)
#pragma unroll
      for (int nq = 0; nq < NQ; ++nq)
#pragma unroll
        for (int j = 0; j < 4; ++j) {
          const size_t idx = (size_t)(mt_ * 256 + wm * 128 + mt * 16 + quad * 4 + j) * DM + nt * 256 + wn * 64 + nq * 16 + r16;
          hout[idx] = hin[idx] + acc[mt][nq][j];
        }
  }
}

DI_ void ssm_pre_phase(const Params& p, float* sm, bf16_t* WgT, bf16_t* YgT, float* lamL) {
  int tid_ = threadIdx.x; asm volatile("" : "+v"(tid_)); const int tid = tid_;
  const float *a_re = p.in[11], *a_im = p.in[12], *log_step = p.in[13], *b_re = p.in[14], *b_im = p.in[15];
  const float *c_re = p.in[16], *c_im = p.in[17], *d_skip = p.in[18];
  float* lp_re = sm;
  float* lp_im = sm + 17 * 64;
  float* bb_re = sm + 34 * 64;
  float* bb_im = bb_re + 1024;
  float* cc_re = bb_im + 1024;
  float* cc_im = cc_re + 1024;
  float* cf = cc_im + 1024;
  float* Kt = cf + 128;
  for (int item = blockIdx.x; item < 256; item += gridDim.x) {
    const int g = item >> 1, half = item & 1;
    __syncthreads();
    if (tid < 64) {
      const float st = expf(log_step[g]);
      const float ar = a_re[g * 64 + tid], ai = a_im[g * 64 + tid];
      const float zr = ar * st, zi = ai * st;
      for (int tau = 0; tau <= 16; ++tau) {
        float e = expf(zr * (float)tau), sn, cs;
        sincos_red(zi * (float)tau, &sn, &cs);
        lp_re[tau * 64 + tid] = e * cs; lp_im[tau * 64 + tid] = e * sn;
      }
      float sn, cs; sincos_red(zi, &sn, &cs);
      float sh, ch; sincos_red(0.5f * zi, &sh, &ch);
      const float em1 = expm1f(zr);
      const float nr = em1 * cs - 2.f * sh * sh, ni = (em1 + 1.f) * sn;
      const float den = 1.f / (ar * ar + ai * ai);
      cf[tid] = (nr * ar + ni * ai) * den; cf[64 + tid] = (ni * ar - nr * ai) * den;
    }
    __syncthreads();
    for (int e = tid; e < 1024; e += NT) {
      const int pp = e >> 4;
      const float br = b_re[(size_t)g * 1024 + e], bi = b_im[(size_t)g * 1024 + e];
      const float cr = cf[pp], ci = cf[64 + pp];
      bb_re[e] = cr * br - ci * bi; bb_im[e] = cr * bi + ci * br;
      cc_re[e] = c_re[(size_t)g * 1024 + e]; cc_im[e] = c_im[(size_t)g * 1024 + e];
    }
    __syncthreads();
    for (int e = tid; e < 4096; e += NT) {
      const int tau = e >> 8, ho = (e >> 4) & 15, hi = e & 15;
      float acc = 0.f;
      for (int pp = 0; pp < 64; ++pp) {
        const float cr = cc_re[ho * 64 + pp], ci = cc_im[ho * 64 + pp];
        const float lr = lp_re[tau * 64 + pp], li = lp_im[tau * 64 + pp];
        const float dr = cr * lr - ci * li, di = cr * li + ci * lr;
        acc += dr * bb_re[pp * 16 + hi] - di * bb_im[pp * 16 + hi];
      }
      if (tau == 0 && ho == hi) acc += d_skip[g * 16 + ho];
      Kt[e] = acc;
    }
    __syncthreads();
    for (int e = half * 32768 + tid; e < (half + 1) * 32768; e += NT) {
      const int n = e >> 8, k = e & 255, t = n >> 4, ho = n & 15, sx = k >> 4, hi = k & 15;
      const float v = (sx <= t) ? Kt[((t - sx) * 16 + ho) * 16 + hi] : 0.f;
      YgT[((size_t)g * 256 + n) * 384 + k] = f2bf(v);
    }
    for (int e = half * 8192 + tid; e < (half + 1) * 8192; e += NT) {
      const int n = e >> 6, pp = e & 63, t = n >> 4, ho = n & 15;
      const float cr = cc_re[ho * 64 + pp], ci = cc_im[ho * 64 + pp];
      const float lr = lp_re[(t + 1) * 64 + pp], li = lp_im[(t + 1) * 64 + pp];
      YgT[((size_t)g * 256 + n) * 384 + 256 + pp] = f2bf(cr * lr - ci * li);
      YgT[((size_t)g * 256 + n) * 384 + 320 + pp] = f2bf(-(cr * li + ci * lr));
    }
    for (int e = half * 8192 + tid; e < (half + 1) * 8192; e += NT) {
      const int pp = e >> 8, k = e & 255, j = k >> 4, hh = k & 15;
      const float lr = lp_re[(15 - j) * 64 + pp], li = lp_im[(15 - j) * 64 + pp];
      const float br = bb_re[pp * 16 + hh], bi = bb_im[pp * 16 + hh];
      WgT[((size_t)g * 128 + pp) * 256 + k] = f2bf(lr * br - li * bi);
      WgT[((size_t)g * 128 + 64 + pp) * 256 + k] = f2bf(lr * bi + li * br);
    }
    if (tid < 64) { lamL[g * 128 + tid] = lp_re[16 * 64 + tid]; lamL[g * 128 + 64 + tid] = lp_im[16 * 64 + tid]; }
  }
}

DI_ void s5_inu_phase(const bf16_t* HB, const bf16_t* WinT, bf16_t* Uc, bf16_t* smem) {
  TILE_IDS(); CFG_A16();
  for (int t = blockIdx.x; t < 64 * 8; t += gridDim.x) {
    const int mt_ = (t & 7) + 8 * (t >> 6), nt = (t >> 3) & 7;
    GemmArgs g{HB + (size_t)mt_ * 256 * DM, DM, nullptr, 0, 1 << 30, WinT + (size_t)nt * 256 * DM, DM, 16};
    f32x4 acc[MT][NQ];
    gemm_mainloop16<WM, WN, MT, NQ>(g, smem, acc);
    {
      bf16_t* st = smem + w * (128 * LDS_STRIDE);
#pragma unroll
      for (int mt = 0; mt < MT; ++mt)
#pragma unroll
        for (int nq = 0; nq < NQ; ++nq)
#pragma unroll
          for (int j = 0; j < 4; ++j) {
            const int rl = mt * 16 + quad * 4 + j, cl = nq * 16 + r16;
            st[((cl >> 4) * 8 + (rl >> 4)) * 256 + (rl & 15) * 16 + (cl & 15)] = f2bf(acc[mt][nq][j]);
          }
      stage_sync();
      const int g0 = (nt * 256 + wn * 64) >> 4, n0 = (mt_ * 256 + wm * 128) >> 4;
#pragma unroll 4
      for (int it = 0; it < 16; ++it) {
        const int blk = it * 2 + (lane >> 5), gl = blk >> 3, nl = blk & 7;
        const uint4 v = *(const uint4*)(st + blk * 256 + (lane & 31) * 8);
        *(uint4*)(Uc + ((size_t)(g0 + gl) * 1024 + n0 + nl) * 256 + (lane & 31) * 8) = v;
      }
      stage_sync();
    }
  }
}
DI_ void s5_inz_phase(const bf16_t* HB, const bf16_t* WinTz, bf16_t* Z, bf16_t* smem) {
  TILE_IDS(); CFG_A16();
  for (int t = blockIdx.x; t < 64 * 8; t += gridDim.x) {
    const int mt_ = (t & 7) + 8 * (t >> 6), nt = (t >> 3) & 7;
    GemmArgs g{HB + (size_t)mt_ * 256 * DM, DM, nullptr, 0, 1 << 30, WinTz + (size_t)nt * 256 * DM, DM, 16};
    f32x4 acc[MT][NQ];
    gemm_mainloop16<WM, WN, MT, NQ>(g, smem, acc);
    bf16_t* st = wave_stage<128>(smem, w);
#pragma unroll
    for (int mt = 0; mt < MT; ++mt)
#pragma unroll
      for (int nq = 0; nq < NQ; ++nq)
#pragma unroll
        for (int j = 0; j < 4; ++j)
          st[(mt * 16 + quad * 4 + j) * LDS_STRIDE + nq * 16 + r16] = f2bf(siluf_(acc[mt][nq][j]));
    stage_flush<128, 64>(st, Z + (size_t)(mt_ * 256 + wm * 128) * DIN + nt * 256 + wn * 64, DIN, lane);
  }
}
DI_ void s5_sgemm_phase(const bf16_t* Uc, const bf16_t* WgT, const float* lamL, bf16_t* Sx, bf16_t* smem) {
  TILE_IDS(); CFG_B16();
  float* Sl = (float*)smem;
  float* xch = Sl + 256 * 129;
  for (int t = blockIdx.x; t < 128 * 4; t += gridDim.x) {
    const int gi = t >> 2, mt_ = t & 3;
    GemmArgs g{Uc + ((size_t)gi * 1024 + mt_ * 256) * 256, 256, nullptr, 0, 1 << 30, WgT + (size_t)gi * 128 * 256, 256, 4};
    f32x4 acc[MT][NQ];
    gemm_mainloop16<WM, WN, MT, NQ>(g, smem, acc);
#pragma unroll
    for (int mt = 0; mt < MT; ++mt)
#pragma unroll
      for (int nq = 0; nq < NQ; ++nq)
#pragma unroll
        for (int j = 0; j < 4; ++j)
          Sl[(wm * 64 + mt * 16 + quad * 4 + j) * 129 + wn * 64 + nq * 16 + r16] = acc[mt][nq][j];
    __syncthreads();
    {
      const int pp = tid & 63, seg = tid >> 6;
      const float lr = lamL[gi * 128 + pp], li = lamL[gi * 128 + 64 + pp];
      const float* sp = Sl + (seg * 32) * 129 + pp;
      float xr = 0.f, xi = 0.f;
#pragma unroll 8
      for (int c = 0; c < 32; ++c) { const float sr = sp[c * 129], si = sp[c * 129 + 64]; const float tt = lr * xr - li * xi + sr; xi = lr * xi + li * xr + si; xr = tt; }
      xch[seg * 128 + pp] = xr; xch[seg * 128 + 64 + pp] = xi;
      __syncthreads();
      float ar = lr, ai = li;
#pragma unroll
      for (int q = 0; q < 5; ++q) { const float tt = ar * ar - ai * ai; ai = 2.f * ar * ai; ar = tt; }
      xr = 0.f; xi = 0.f;
      for (int s2 = 0; s2 < seg; ++s2) { const float tt = ar * xr - ai * xi + xch[s2 * 128 + pp]; xi = ar * xi + ai * xr + xch[s2 * 128 + 64 + pp]; xr = tt; }
      bf16_t* base = Sx + ((size_t)(mt_ * 256 + seg * 32) * 128 + gi) * 128 + pp;
#pragma unroll 8
      for (int c = 0; c < 32; ++c) {
        base[(size_t)c * 16384] = f2bf(xr); base[(size_t)c * 16384 + 64] = f2bf(xi);
        const float sr = sp[c * 129], si = sp[c * 129 + 64];
        const float tt = lr * xr - li * xi + sr; xi = lr * xi + li * xr + si; xr = tt;
      }
    }
  }
}
DI_ void s5_scan_phase(bf16_t* Sx, const float* lamL, float* sm) {
  int tid_ = threadIdx.x; asm volatile("" : "+v"(tid_)); const int tid = tid_;
  const int pp = tid & 63, seg = tid >> 6;
  for (int item = blockIdx.x; item < 512; item += gridDim.x) {
    const int b = item >> 7, g = item & 127;
    const float lr = lamL[g * 128 + pp], li = lamL[g * 128 + 64 + pp];
    bf16_t* base = Sx + ((size_t)(b * 256 + seg * 32) * 128 + g) * 128 + pp;
    float xr = 0.f, xi = 0.f;
    for (int c0 = 0; c0 < 32; c0 += 8) {
      float sr[8], si[8];
#pragma unroll
      for (int c = 0; c < 8; ++c) { sr[c] = bf2f(base[(size_t)(c0 + c) * 16384]); si[c] = bf2f(base[(size_t)(c0 + c) * 16384 + 64]); }
#pragma unroll
      for (int c = 0; c < 8; ++c) { const float t = lr * xr - li * xi + sr[c]; xi = lr * xi + li * xr + si[c]; xr = t; }
    }
    __syncthreads();
    sm[seg * 128 + pp] = xr; sm[seg * 128 + 64 + pp] = xi;
    __syncthreads();
    float ar = lr, ai = li;
#pragma unroll
    for (int q = 0; q < 5; ++q) { const float t = ar * ar - ai * ai; ai = 2.f * ar * ai; ar = t; }
    xr = 0.f; xi = 0.f;
    for (int s2 = 0; s2 < seg; ++s2) { const float t = ar * xr - ai * xi + sm[s2 * 128 + pp]; xi = ar * xi + ai * xr + sm[s2 * 128 + 64 + pp]; xr = t; }
    for (int c0 = 0; c0 < 32; c0 += 8) {
      float sr[8], si[8];
#pragma unroll
      for (int c = 0; c < 8; ++c) { sr[c] = bf2f(base[(size_t)(c0 + c) * 16384]); si[c] = bf2f(base[(size_t)(c0 + c) * 16384 + 64]); }
#pragma unroll
      for (int c = 0; c < 8; ++c) {
        base[(size_t)(c0 + c) * 16384] = f2bf(xr); base[(size_t)(c0 + c) * 16384 + 64] = f2bf(xi);
        const float t = lr * xr - li * xi + sr[c]; xi = lr * xi + li * xr + si[c]; xr = t;
      }
    }
  }
}
DI_ void s5_ygemm_phase(const bf16_t* Uc, const bf16_t* Sx, const bf16_t* YgT, bf16_t* Y, bf16_t* smem) {
  TILE_IDS(); CFG_A16();
  for (int t = blockIdx.x; t < 128 * 4; t += gridDim.x) {
    const int xq = t & 7, kq = t >> 3;
    const int gi = xq * 16 + (kq >> 2), mt_ = kq & 3;
    GemmArgs g{Uc + ((size_t)gi * 1024 + mt_ * 256) * 256, 256, Sx + ((size_t)mt_ * 256 * 128 + gi) * 128, 16384, 4,
               YgT + (size_t)gi * 256 * 384, 384, 6};
    f32x4 acc[MT][NQ];
    gemm_mainloop16<WM, WN, MT, NQ>(g, smem, acc);
#pragma unroll
    for (int mt = 0; mt < MT; ++mt)
#pragma unroll
      for (int nq = 0; nq < NQ; ++nq)
#pragma unroll
        for (int j = 0; j < 4; ++j) {
          const int row = mt_ * 256 + wm * 128 + mt * 16 + quad * 4 + j;
          Y[((size_t)row * 16 + wn * 4 + nq) * DIN + gi * 16 + r16] = f2bf(geluf_(acc[mt][nq][j]));
        }
  }
}
DI_ void s5_glu_phase(const bf16_t* HB, const bf16_t* WinTz, const bf16_t* Y, const bf16_t* WgluT, const float* b_glu, bf16_t* Z, bf16_t* smem) {
  TILE_IDS(); CFG_A16();
  for (int t = blockIdx.x; t < 64 * 8; t += gridDim.x) {
    const int mt_ = (t & 7) + 8 * (t >> 6), nt = (t >> 3) & 7;
    f32x4 acc[MT][NQ];
    {
      GemmArgs gz{HB + (size_t)mt_ * 256 * DM, DM, nullptr, 0, 1 << 30, WinTz + (size_t)nt * 256 * DM, DM, 16};
      gemm_mainloop16<WM, WN, MT, NQ>(gz, smem, acc);
      bf16_t* stz = wave_stage<128>(smem, w);
#pragma unroll
      for (int mt = 0; mt < MT; ++mt)
#pragma unroll
        for (int nq = 0; nq < NQ; ++nq)
#pragma unroll
          for (int j = 0; j < 4; ++j)
            stz[(mt * 16 + quad * 4 + j) * LDS_STRIDE + nq * 16 + r16] = f2bf(siluf_(acc[mt][nq][j]));
      stage_flush<128, 64>(stz, Z + (size_t)(mt_ * 256 + wm * 128) * DIN + nt * 256 + wn * 64, DIN, lane);
    }
    GemmArgs g{Y + (size_t)mt_ * 256 * DIN, DIN, nullptr, 0, 1 << 30, WgluT + (size_t)nt * 256 * DIN, DIN, 32};
    gemm_mainloop16<WM, WN, MT, NQ>(g, smem, acc);
    {
      bf16_t* stY = smem + w * (128 * LDS_STRIDE);
      bf16_t* stZ = stY + 64 * LDS_STRIDE;
      const float* bgp = b_glu + nt * 256 + wn * 64 + r16;
      const float bg0 = bgp[0], bg1 = bgp[16], bg2 = bgp[32], bg3 = bgp[48];
#pragma unroll
      for (int h2 = 0; h2 < 2; ++h2) {
        const size_t off = (size_t)(mt_ * 256 + wm * 128 + h2 * 64) * DIN + nt * 256 + wn * 64;
        stage_load<64, 64>(stY, Y + off, DIN, lane);
        stage_load<64, 64>(stZ, Z + off, DIN, lane);
#pragma unroll
        for (int m2 = 0; m2 < 4; ++m2)
#pragma unroll
          for (int nq = 0; nq < NQ; ++nq)
#pragma unroll
            for (int j = 0; j < 4; ++j) {
              const int idx = (m2 * 16 + quad * 4 + j) * LDS_STRIDE + nq * 16 + r16;
              const float yv = bf2f(stY[idx]);
              stZ[idx] = f2bf(yv * sigmoidf_(acc[h2 * 4 + m2][nq][j] + (nq == 0 ? bg0 : nq == 1 ? bg1 : nq == 2 ? bg2 : bg3)) * bf2f(stZ[idx]));
            }
        stage_flush<64, 64>(stZ, Z + off, DIN, lane);
      }
    }
  }
}

DI_ void mla_wq_phase(const float* w_uq, const float* w_ukv, const float* gq, const float* gkv, bf16_t* WqT, float* sm) {
  int tid_ = threadIdx.x; asm volatile("" : "+v"(tid_)); const int tid = tid_;
  float* As = sm;
  float* Bs = sm + 32 * 129;
  float* Os = Bs + 128 * 129;
  for (int item = blockIdx.x; item < 16 * 12; item += gridDim.x) {
    const int h = item / 12, c0 = (item % 12) * 32;
    __syncthreads();
#pragma unroll
    for (int q = 0; q < 2; ++q) {
      const int e = tid + q * NT, ci = e >> 5, d4 = e & 31;
      const float4 v = *(const float4*)(w_uq + (size_t)(c0 + ci) * 3072 + h * 192 + d4 * 4);
      float* p_ = As + ci * 129 + d4 * 4; p_[0] = v.x; p_[1] = v.y; p_[2] = v.z; p_[3] = v.w;
    }
#pragma unroll
    for (int q = 0; q < 8; ++q) {
      const int e = tid + q * NT, rr = e >> 5, d4 = e & 31;
      const float4 v = *(const float4*)(w_ukv + (size_t)rr * 4096 + h * 256 + d4 * 4);
      float* p_ = Bs + rr * 129 + d4 * 4; p_[0] = v.x; p_[1] = v.y; p_[2] = v.z; p_[3] = v.w;
    }
    __syncthreads();
    {
      const int rr = tid & 127, cg = tid >> 7;
      float acc[8];
#pragma unroll
      for (int j = 0; j < 8; ++j) acc[j] = 0.f;
      for (int d = 0; d < 128; ++d) {
        const float bv = Bs[rr * 129 + d];
#pragma unroll
        for (int j = 0; j < 8; ++j) acc[j] += As[(cg + 4 * j) * 129 + d] * bv;
      }
      const float gk = gkv[rr];
#pragma unroll
      for (int j = 0; j < 8; ++j) Os[rr * 33 + cg + 4 * j] = acc[j] * gk * gq[c0 + cg + 4 * j];
    }
    __syncthreads();
#pragma unroll
    for (int q = 0; q < 8; ++q) {
      const int e = tid + q * NT, rr = e >> 5, ci = e & 31;
      WqT[(size_t)(h * 192 + rr) * 384 + c0 + ci] = f2bf(Os[rr * 33 + ci]);
    }
  }
  for (int idx = blockIdx.x * NT + tid; idx < 16 * 64 * 384; idx += gridDim.x * NT) {
    const int c = idx % 384, nn = idx / 384, h = nn >> 6, j = nn & 63, n = h * 192 + 128 + j;
    WqT[(size_t)n * 384 + c] = f2bf(w_uq[(size_t)c * 3072 + n] * gq[c]);
  }
}
DI_ void rope_table_phase(const int* pos, float* cosT, float* sinT) {
  for (int idx = blockIdx.x * NT + threadIdx.x; idx < T_TOK * 32; idx += gridDim.x * NT) {
    const float ang = (float)pos[idx >> 5] * INVF[idx & 31];
    float sn, cs; sincos_red(ang, &sn, &cs);
    cosT[idx] = cs; sinT[idx] = sn;
  }
}
DI_ void mla_in_phase(const bf16_t* HB, const bf16_t* WinT, bf16_t* cq, float* qssq, float* ckv, bf16_t* Kc, bf16_t* Z,
                      const float* cosT, const float* sinT, bf16_t* smem) {
  TILE_IDS(); CFG_A16();
  for (int t = blockIdx.x; t < 64 * 11; t += gridDim.x) {
    const int mt_ = (t & 7) + 8 * (t / 88), nt = (t >> 3) % 11;
    GemmArgs g{HB + (size_t)mt_ * 256 * DM, DM, nullptr, 0, 1 << 30, WinT + (size_t)nt * 256 * DM, DM, 16};
    f32x4 acc[MT][NQ];
    gemm_mainloop16<WM, WN, MT, NQ>(g, smem, acc);
    const int rbase = mt_ * 256 + wm * 128;
    const int cb = nt * 4 + wn;
    bf16_t* st = wave_stage<128>(smem, w);
    if (cb < 6) {
#pragma unroll
      for (int mt = 0; mt < MT; ++mt)
#pragma unroll
        for (int nq = 0; nq < NQ; ++nq)
#pragma unroll
          for (int j = 0; j < 4; ++j)
            st[(mt * 16 + quad * 4 + j) * LDS_STRIDE + nq * 16 + r16] = f2bf(acc[mt][nq][j]);
      stage_rowstats<128>(st, lane, [&](int row, float s1, float s2) { (void)s1; qssq[(size_t)(rbase + row) * 8 + cb] = s2; });
      stage_flush<128, 64>(st, cq + (size_t)rbase * 384 + cb * 64, 384, lane);
    } else if (cb < 8) {
#pragma unroll
      for (int mt = 0; mt < MT; ++mt)
#pragma unroll
        for (int nq = 0; nq < NQ; ++nq)
#pragma unroll
          for (int j = 0; j < 4; ++j)
            ckv[(size_t)(rbase + mt * 16 + quad * 4 + j) * 128 + (cb - 6) * 64 + nq * 16 + r16] = acc[mt][nq][j];
    } else if (cb == 8) {
#pragma unroll
      for (int mt = 0; mt < MT; ++mt) {
#pragma unroll
        for (int nq = 0; nq < 2; ++nq)
#pragma unroll
          for (int j = 0; j < 4; ++j) {
            const int row = rbase + mt * 16 + quad * 4 + j, jj = nq * 16 + r16;
            const float cs = cosT[(size_t)row * 32 + jj], sn = sinT[(size_t)row * 32 + jj];
            const float x1 = acc[mt][nq][j], x2 = acc[mt][nq + 2][j];
            Kc[(size_t)row * 192 + 128 + jj] = f2bf(x1 * cs - x2 * sn);
            Kc[(size_t)row * 192 + 160 + jj] = f2bf(x2 * cs + x1 * sn);
          }
        asm volatile("" ::: "memory");
      }
    } else if (cb >= 10 && cb < 42) {
#pragma unroll
      for (int mt = 0; mt < MT; ++mt)
#pragma unroll
        for (int nq = 0; nq < NQ; ++nq)
#pragma unroll
          for (int j = 0; j < 4; ++j)
            st[(mt * 16 + quad * 4 + j) * LDS_STRIDE + nq * 16 + r16] = f2bf(siluf_(acc[mt][nq][j]));
      stage_flush<128, 64>(st, Z + (size_t)rbase * DIN + (cb - 10) * 64, DIN, lane);
    }
  }
}
DI_ void mla_q_phase(const bf16_t* cq, const float* qssq, const bf16_t* WqT, bf16_t* Qp, const float* cosT, const float* sinT,
                     const float* ckv, bf16_t* Kc, bf16_t* KcT, bf16_t* smem) {
  TILE_IDS(); CFG_A16();
  const float QSC = 0.07216878364870322f * 1.4426950408889634f;
  float* fsc = (float*)((unsigned char*)smem + SMEM_MAIN);
  for (int t = blockIdx.x; t < 64 * 12; t += gridDim.x) {
    const int mt_ = (t & 7) + 8 * (t / 96), nt = (t >> 3) % 12;
    GemmArgs g{cq + (size_t)mt_ * 256 * 384, 384, nullptr, 0, 1 << 30, WqT + (size_t)nt * 256 * 384, 384, 6};
    f32x4 acc[MT][NQ];
    __syncthreads();
    if (tid < 256) {
      const float* ps = qssq + (size_t)(mt_ * 256 + tid) * 8;
      const float ss = ps[0] + ps[1] + ps[2] + ps[3] + ps[4] + ps[5];
      fsc[tid] = rsqrtf(ss * (1.f / 384.f) + 1e-6f) * QSC;
    }
    gemm_mainloop16s<WM, WN, MT, NQ>(g, smem, acc);
    const int cb = nt * 4 + wn;
    const bool is_rope = (cb % 3) == 2;
    const int colb = cb * 64;
    bf16_t* st = wave_stage<128>(smem, w);
#pragma unroll
    for (int mt = 0; mt < MT; ++mt) {
#pragma unroll
      for (int nq = 0; nq < 2; ++nq)
#pragma unroll
        for (int j = 0; j < 4; ++j) {
          const int rl = mt * 16 + quad * 4 + j, jj = nq * 16 + r16;
          const float f = fsc[wm * 128 + rl];
          float x1 = acc[mt][nq][j] * f, x2 = acc[mt][nq + 2][j] * f;
          if (is_rope) {
            const int row = mt_ * 256 + wm * 128 + rl;
            const float cs = cosT[(size_t)row * 32 + jj], sn = sinT[(size_t)row * 32 + jj];
            const float y1 = x1 * cs - x2 * sn, y2 = x2 * cs + x1 * sn;
            x1 = y1; x2 = y2;
          }
          st[rl * LDS_STRIDE + jj] = f2bf(x1);
          st[rl * LDS_STRIDE + 32 + jj] = f2bf(x2);
        }
      asm volatile("" ::: "memory");
      __builtin_amdgcn_sched_barrier(0);
    }
    stage_flush<128, 64>(st, Qp + (size_t)(mt_ * 256 + wm * 128) * 3072 + colb, 3072, lane);
  }
  float* tl = (float*)smem;
  float* rs = tl + 64 * 129;
  for (int item = blockIdx.x; item < T_TOK / 64; item += gridDim.x) {
    const int t0 = item * 64;
    __syncthreads();
    for (int e = tid; e < 64 * 128; e += NT) tl[(e >> 7) * 129 + (e & 127)] = ckv[(size_t)t0 * 128 + e];
    __syncthreads();
    {
      const int tok = tid >> 3, part = tid & 7;
      float ss = 0.f;
      for (int j = 0; j < 16; ++j) { const float v = tl[tok * 129 + part * 16 + j]; ss += v * v; }
      ss += __shfl_xor(ss, 1); ss += __shfl_xor(ss, 2); ss += __shfl_xor(ss, 4);
      if (part == 0) rs[tok] = rsqrtf(ss * (1.f / 128.f) + 1e-6f);
    }
    __syncthreads();
    for (int e = tid; e < 64 * 128; e += NT) {
      const int tok = e >> 7, rr = e & 127;
      Kc[(size_t)(t0 + tok) * 192 + rr] = f2bf(tl[tok * 129 + rr] * rs[tok]);
    }
    const int b = t0 >> 12, l0 = t0 & 4095;
    for (int e = tid; e < 64 * 128; e += NT) {
      const int rr = e >> 6, tok = e & 63;
      KcT[((size_t)b * 128 + rr) * SEQ + l0 + tok] = f2bf(tl[tok * 129 + rr] * rs[tok]);
    }
  }
}

constexpr int KT = 64;
constexpr int NSUB = KT / 32;
constexpr int KS_STRIDE = 200;
constexpr int VS_STRIDE = KT + 4;
DI_ void mla_attn_phase(const bf16_t* Qp, const bf16_t* Kc, const bf16_t* KcT, const bf16_t* WuvT, bf16_t* Z, bf16_t* smem) {
  TILE_IDS();
  bf16_t* Ks = smem;
  bf16_t* Vs = smem + KT * KS_STRIDE;
  bf16_t* Ws = smem + 36864;
  const int G = gridDim.x;
  for (int round = 0;; ++round) {
    const int slot = (round & 1) ? (G - 1 - (int)blockIdx.x) : (int)blockIdx.x;
    const int item = round * G + slot;
    if (item >= 1024) break;
    const int qb = 15 - (item >> 6), bh = item & 63, b = bh >> 4, h = bh & 15;
    const int q0 = qb * 256, qw0 = q0 + w * 32, qrow = qw0 + r;
    const size_t tok = (size_t)b * SEQ + qrow;
    bf16x8 qf[12];
    {
      const bf16_t* qptr = Qp + tok * 3072 + h * 192 + hf * 8;
#pragma unroll
      for (int ks = 0; ks < 12; ++ks) qf[ks] = *(const bf16x8*)(qptr + ks * 16);
    }
    {
      const bf16_t* wsrc = WuvT + (size_t)h * 128 * 128;
#pragma unroll
      for (int i = 0; i < 4; ++i) {
        const int row = i * 32 + (tid >> 4), slot = tid & 15;
        __builtin_amdgcn_global_load_lds((const unsigned*)(wsrc + row * 128 + ((slot ^ (row & 15)) * 8)), (unsigned*)(Ws + (i * NT + tid) * 8), 16, 0, 0);
      }
    }
    f32x16 O[4];
#pragma unroll
    for (int dt = 0; dt < 4; ++dt)
#pragma unroll
      for (int i = 0; i < 16; ++i) O[dt][i] = 0.f;
    float m = -1e30f, ls = 0.f;
    const int ntile = (q0 + 256) / KT;
    const bf16_t* Kg = Kc + (size_t)b * SEQ * 192;
    const bf16_t* Vg = KcT + (size_t)b * 128 * SEQ;
    const int kc0 = tid, kc1 = tid + 512, kc2 = tid + 1024;
    const int kr0 = kc0 / 24, kr1 = kc1 / 24, kr2 = kc2 / 24;
    const int ko0 = kr0 * 192 + (kc0 - kr0 * 24) * 8, ko1 = kr1 * 192 + (kc1 - kr1 * 24) * 8, ko2 = kr2 * 192 + (kc2 - kr2 * 24) * 8;
    const int kl0 = kr0 * KS_STRIDE + (kc0 - kr0 * 24) * 8, kl1 = kr1 * KS_STRIDE + (kc1 - kr1 * 24) * 8, kl2 = kr2 * KS_STRIDE + (kc2 - kr2 * 24) * 8;
    const int vr0 = tid >> 3, vr1 = (tid + 512) >> 3, vcc = (tid & 7) * 8;
    uint4 rk0 = *(const uint4*)(Kg + ko0), rk1 = *(const uint4*)(Kg + ko1), rk2 = *(const uint4*)(Kg + ko2);
    uint4 rv0 = *(const uint4*)(Vg + (size_t)vr0 * SEQ + vcc), rv1 = *(const uint4*)(Vg + (size_t)vr1 * SEQ + vcc);
    for (int kt = 0; kt < ntile; ++kt) {
      __syncthreads();
      *(uint4*)(Ks + kl0) = rk0; *(uint4*)(Ks + kl1) = rk1; *(uint4*)(Ks + kl2) = rk2;
      { uint2 lo, hi; lo.x = rv0.x; lo.y = rv0.y; hi.x = rv0.z; hi.y = rv0.w;
        *(uint2*)(Vs + vr0 * VS_STRIDE + vcc) = lo; *(uint2*)(Vs + vr0 * VS_STRIDE + vcc + 4) = hi; }
      { uint2 lo, hi; lo.x = rv1.x; lo.y = rv1.y; hi.x = rv1.z; hi.y = rv1.w;
        *(uint2*)(Vs + vr1 * VS_STRIDE + vcc) = lo; *(uint2*)(Vs + vr1 * VS_STRIDE + vcc + 4) = hi; }
      __syncthreads();
      if (kt + 1 < ntile) {
        const int k1 = (kt + 1) * KT;
        const bf16_t* Kn = Kg + (size_t)k1 * 192;
        rk0 = *(const uint4*)(Kn + ko0); rk1 = *(const uint4*)(Kn + ko1); rk2 = *(const uint4*)(Kn + ko2);
        rv0 = *(const uint4*)(Vg + (size_t)vr0 * SEQ + k1 + vcc); rv1 = *(const uint4*)(Vg + (size_t)vr1 * SEQ + k1 + vcc);
      }
      const int k0 = kt * KT;
      if (k0 <= qw0 + 31) {
        f32x16 st[NSUB];
#pragma unroll
        for (int sub = 0; sub < NSUB; ++sub) {
#pragma unroll
          for (int i = 0; i < 16; ++i) st[sub][i] = 0.f;
#pragma unroll
          for (int ks = 0; ks < 12; ++ks) {
            bf16x8 a = *(const bf16x8*)(Ks + (sub * 32 + r) * KS_STRIDE + ks * 16 + hf * 8);
            st[sub] = MFMA32(a, qf[ks], st[sub]);
            if ((ks & 3) == 3) __builtin_amdgcn_sched_barrier(0);
          }
        }
        if (k0 + KT - 1 > qw0) {
#pragma unroll
          for (int sub = 0; sub < NSUB; ++sub)
#pragma unroll
            for (int i = 0; i < 16; ++i)
              if (k0 + sub * 32 + crow(i, hf) > qrow) st[sub][i] = -1e30f;
        }
        float mx = -1e30f;
#pragma unroll
        for (int sub = 0; sub < NSUB; ++sub)
#pragma unroll
          for (int i = 0; i < 16; ++i) mx = fmaxf(mx, st[sub][i]);
        mx = fmaxf(mx, __shfl_xor(mx, 32));
        if (!__all(mx - m <= 8.f)) {
          const float mn = fmaxf(m, mx);
          const float alpha = __builtin_amdgcn_exp2f(m - mn);
          m = mn;
          ls *= alpha;
#pragma unroll
          for (int dt = 0; dt < 4; ++dt)
#pragma unroll
            for (int i = 0; i < 16; ++i) O[dt][i] *= alpha;
        }
        float psum = 0.f;
#pragma unroll
        for (int sub = 0; sub < NSUB; ++sub)
#pragma unroll
          for (int i = 0; i < 16; ++i) { const float pv = __builtin_amdgcn_exp2f(st[sub][i] - m); st[sub][i] = pv; psum += pv; }
        ls += psum;
#pragma unroll
        for (int sub = 0; sub < NSUB; ++sub)
#pragma unroll
          for (int s2 = 0; s2 < 2; ++s2) {
            u32x4 pfu;
#pragma unroll
            for (int j = 0; j < 4; ++j) pfu[j] = pack2(st[sub][8 * s2 + 2 * j], st[sub][8 * s2 + 2 * j + 1]);
            const bf16x8 pf = __builtin_bit_cast(bf16x8, pfu);
#pragma unroll
            for (int dt = 0; dt < 4; ++dt) {
              const bf16_t* vp = Vs + (dt * 32 + r) * VS_STRIDE + sub * 32 + s2 * 16 + hf * 4;
              const uint2 vlo = *(const uint2*)vp;
              const uint2 vhi = *(const uint2*)(vp + 8);
              u32x4 vau; vau[0] = vlo.x; vau[1] = vlo.y; vau[2] = vhi.x; vau[3] = vhi.y;
              O[dt] = MFMA32(__builtin_bit_cast(bf16x8, vau), pf, O[dt]);
            }
          }
      }
    }
    const float lt = ls + __shfl_xor(ls, 32);
    const float inv = 1.f / lt;
    f32x16 U[4];
#pragma unroll
    for (int dq = 0; dq < 4; ++dq)
#pragma unroll
      for (int i = 0; i < 16; ++i) U[dq][i] = 0.f;
#pragma unroll
    for (int dt = 0; dt < 4; ++dt)
#pragma unroll
      for (int s2 = 0; s2 < 2; ++s2) {
        u32x4 ofu;
#pragma unroll
        for (int j = 0; j < 4; ++j) ofu[j] = pack2(O[dt][8 * s2 + 2 * j] * inv, O[dt][8 * s2 + 2 * j + 1] * inv);
        const bf16x8 of = __builtin_bit_cast(bf16x8, ofu);
        const int dv0 = dt * 32 + s2 * 16 + hf * 4;
        const int c0 = dv0 >> 3, hb = (dv0 & 7);
#pragma unroll
        for (int dq = 0; dq < 4; ++dq) {
          const int R = dq * 32 + r;
          const uint2 wlo = *(const uint2*)(Ws + R * 128 + ((c0 ^ (R & 15)) * 8) + hb);
          const uint2 whi = *(const uint2*)(Ws + R * 128 + (((c0 + 1) ^ (R & 15)) * 8) + hb);
          u32x4 wau; wau[0] = wlo.x; wau[1] = wlo.y; wau[2] = whi.x; wau[3] = whi.y;
          U[dq] = MFMA32(__builtin_bit_cast(bf16x8, wau), of, U[dq]);
        }
      }
    __syncthreads();
    {
      bf16_t* so = smem + w * (32 * 136);
#pragma unroll
      for (int dq = 0; dq < 4; ++dq)
#pragma unroll
        for (int i4 = 0; i4 < 4; ++i4) {
          uint2 o;
          o.x = pack2(U[dq][i4 * 4 + 0], U[dq][i4 * 4 + 1]);
          o.y = pack2(U[dq][i4 * 4 + 2], U[dq][i4 * 4 + 3]);
          *(uint2*)(so + r * 136 + dq * 32 + i4 * 8 + hf * 4) = o;
        }
      stage_sync();
      bf16_t* zb = Z + ((size_t)b * SEQ + qw0) * DIN + h * 128;
#pragma unroll 4
      for (int it = 0; it < 8; ++it) {
        const int row = it * 4 + (lane >> 4), ch = lane & 15;
        const uint4 uv = *(const uint4*)(so + row * 136 + ch * 8);
        bf16_t* pz = zb + (size_t)row * DIN + ch * 8;
        const uint4 zv = *(const uint4*)pz;
        const unsigned uu[4] = {uv.x, uv.y, uv.z, uv.w}, zz[4] = {zv.x, zv.y, zv.z, zv.w};
        unsigned oo[4];
#pragma unroll
        for (int j = 0; j < 4; ++j)
          oo[j] = pack2(__uint_as_float(uu[j] << 16) * __uint_as_float(zz[j] << 16), __uint_as_float(uu[j] & 0xffff0000u) * __uint_as_float(zz[j] & 0xffff0000u));
        uint4 ov; ov.x = oo[0]; ov.y = oo[1]; ov.z = oo[2]; ov.w = oo[3];
        *(uint4*)pz = ov;
      }
    }
    __syncthreads();
  }
}
DI_ void mla_uv_phase(const bf16_t* Qp, const bf16_t* WuvT, bf16_t* Z, bf16_t* smem) {
  TILE_IDS(); CFG_B();
  for (int t = blockIdx.x; t < 64 * 16; t += gridDim.x) {
    const int mt = t >> 4, h = t & 15;
    GemmArgs g{Qp + (size_t)mt * 256 * 3072 + h * 192, 3072, nullptr, 0, 1 << 30, WuvT + (size_t)h * 128 * 128, 128, 2};
    f32x16 acc[MI][NI];
    gemm_mainloop<WM, WN, MI, NI>(g, smem, acc);
    {
      bf16_t* st = wave_stage<64>(smem, w);
      bf16_t* gp = Z + (size_t)(mt * 256 + wm * 64) * DIN + h * 128 + wn * 64;
      stage_load<64, 64>(st, gp, DIN, lane);
#pragma unroll
      for (int mi = 0; mi < MI; ++mi)
#pragma unroll
        for (int ni = 0; ni < NI; ++ni)
#pragma unroll
          for (int i = 0; i < 16; ++i) {
            bf16_t* pz = st + (mi * 32 + crow(i, hf)) * LDS_STRIDE + ni * 32 + r;
            *pz = f2bf(acc[mi][ni][i] * bf2f(*pz));
          }
      stage_flush<64, 64>(st, gp, DIN, lane);
    }
  }
}

#define XB_TMO      128
#define XB_XCNT(j)  (256  + 64 * (j))
#define XB_XSUB(j)  (1280 + 64 * (j))
#define XB_XGEN(j)  (2304 + 64 * (j))
#define XB_TOP      3328
#define XB_TOPGEN   3392
#define XCD_BAR_WORDS 3456
#define XB_SPIN_CAP (1u << 18)
#define LAS __attribute__((address_space(3)))
DI_ unsigned xb_ld(unsigned* p)              { return __hip_atomic_load(p, __ATOMIC_RELAXED, __HIP_MEMORY_SCOPE_AGENT); }
DI_ unsigned xb_add(unsigned* p, unsigned v) { return __hip_atomic_fetch_add(p, v, __ATOMIC_RELAXED, __HIP_MEMORY_SCOPE_AGENT); }
DI_ unsigned xb_xcc_id() { return (unsigned)__builtin_amdgcn_s_getreg((3 << 11) | 20) & 0xFu; }
#define XB_SPIN(cond, bar) do { unsigned _sp = 0; while (cond) { __builtin_amdgcn_s_sleep(1); \
    if ((++_sp & 255u) == 0u) { if (xb_ld(&(bar)[XB_TMO])) break; if (_sp > XB_SPIN_CAP) { atomicAdd(&(bar)[XB_TMO], 1u); break; } } } } while (0)
struct XcdBarrier { unsigned* bar; unsigned x; volatile LAS unsigned* st; };
DI_ XcdBarrier xcd_barrier_post(unsigned* bar, volatile LAS unsigned* st) {
  XcdBarrier b; b.bar = bar; b.x = xb_xcc_id(); b.st = st;
  if (threadIdx.x == 0) (void)xb_add(&bar[XB_XCNT(b.x)], 1u);
  return b;
}
DI_ void xcd_barrier_complete(unsigned* bar, unsigned x, unsigned& nloc, unsigned& nx) {
  const unsigned G = gridDim.x * gridDim.y * gridDim.z;
  unsigned sum, cnt, mine, sp = 0u;
  for (;;) {
    sum = 0u; cnt = 0u; mine = 0u;
#pragma unroll
    for (unsigned j = 0; j < 16; ++j) { const unsigned c = xb_ld(&bar[XB_XCNT(j)]); sum += c; cnt += (c > 0u) ? 1u : 0u; mine = (j == x) ? c : mine; }
    if (sum == G) break;
    __builtin_amdgcn_s_sleep(1);
    if ((++sp & 255u) == 0u) { if (xb_ld(&bar[XB_TMO])) break; if (sp > XB_SPIN_CAP) { atomicAdd(&bar[XB_TMO], 1u); break; } }
  }
  nloc = mine > 0u ? mine : 1u; nx = cnt > 0u ? cnt : 1u;
}
DI_ void xcd_barrier(const XcdBarrier& b) {
  asm volatile("s_waitcnt vmcnt(0)" ::: "memory");
  __syncthreads();
  if (threadIdx.x == 0) {
    unsigned* bar = b.bar;
    __builtin_amdgcn_s_waitcnt(0);
    unsigned nloc = b.st[0], nx = b.st[1];
    if (nloc == 0u) { xcd_barrier_complete(bar, b.x, nloc, nx); b.st[0] = nloc; b.st[1] = nx; }
    const unsigned old = xb_add(&bar[XB_XSUB(b.x)], 1u);
    const unsigned gen = old / nloc;
    if (old + 1u == (gen + 1u) * nloc) {
      __builtin_amdgcn_fence(__ATOMIC_RELEASE, "agent");
      asm volatile("s_waitcnt vmcnt(0)" ::: "memory");
      const unsigned og = xb_add(&bar[XB_TOP], 1u);
      const unsigned tg = og / nx;
      if (og + 1u == (tg + 1u) * nx) xb_add(&bar[XB_TOPGEN], 1u);
      else XB_SPIN(xb_ld(&bar[XB_TOPGEN]) == tg, bar);
      __builtin_amdgcn_fence(__ATOMIC_ACQUIRE, "agent");
      xb_add(&bar[XB_XGEN(b.x)], 1u);
      asm volatile("s_waitcnt vmcnt(0)" ::: "memory");
    } else {
      XB_SPIN(xb_ld(&bar[XB_XGEN(b.x)]) == gen, bar);
      __builtin_amdgcn_fence(__ATOMIC_ACQUIRE, "agent");
      asm volatile("s_waitcnt vmcnt(0)" ::: "memory");
    }
  }
  __syncthreads();
}

constexpr int NPHASE = 23;

DI_ void gmlp_pre(const Params& p, int base, const float* hsrc, bf16_t* smem) {
  unsigned char* ws = p.ws;
  convT_phase<MAP_GMLP>(p.in[base + 1], 1024, 6144, 6144, p.in[base + 0], (bf16_t*)(ws + W_OFF), (float*)smem);
  convT_phase<MAP_IDENT>(p.in[base + 6], 2048, 1024, 1024, nullptr, (bf16_t*)(ws + W_OFF + 12 * MiB), (float*)smem);
  rownorm_phase(hsrc, (bf16_t*)(ws + HB_OFF));
}

__global__ void __launch_bounds__(512, 2) mega_kernel(Params p, int ph_lo, int ph_hi) {
  extern __shared__ __attribute__((aligned(16))) unsigned char smem_raw[];
  bf16_t* smem = (bf16_t*)smem_raw;
  cg::grid_group grid = cg::this_grid();
  volatile LAS unsigned* xbst = (volatile LAS unsigned*)(smem_raw + SMEM_MAIN + 2048);
  if (threadIdx.x == 0) { xbst[0] = 0u; xbst[1] = 0u; }
  __syncthreads();
  XcdBarrier xb = xcd_barrier_post((unsigned*)(p.ws + BAR_OFF), xbst);
  if (ph_lo < 0) grid.sync();
#define WSP(T, off) ((T*)(p.ws + (size_t)(off)))
#define HB WSP(bf16_t, HB_OFF)
#define B1 WSP(bf16_t, B1_OFF)
#define B2 WSP(bf16_t, B2_OFF)
#define B3 WSP(bf16_t, B3_OFF)
#define gWin WSP(bf16_t, W_OFF)
#define gWout WSP(bf16_t, W_OFF + 12 * MiB)
#define sWin WSP(bf16_t, W_OFF)
#define sWg WSP(bf16_t, 8 * MiB)
#define sYg WSP(bf16_t, 16 * MiB)
#define sWglu WSP(bf16_t, 40 * MiB)
#define sWout WSP(bf16_t, 48 * MiB)
#define sLam WSP(float, 52 * MiB)
#define mWin WSP(bf16_t, W_OFF)
#define mWq WSP(bf16_t, 6 * MiB)
#define mWuv WSP(bf16_t, 9 * MiB)
#define mWout WSP(bf16_t, 10 * MiB)
#define mCq WSP(bf16_t, 14 * MiB)
#define mCkv WSP(float, 26 * MiB)
#define mKc WSP(bf16_t, 34 * MiB)
#define mKcT WSP(bf16_t, 40 * MiB)
#define mQssq WSP(float, 44 * MiB)
#define mCos WSP(float, 45 * MiB)
#define mSin WSP(float, 47 * MiB)
#define mQp B1
#define mZ WSP(bf16_t, 192 * MiB)
#define h (p.out)

#ifndef ONLY
#define ONLY -1
#endif
#ifndef OLO
#define OLO 0
#define OHI 99
#endif
#ifndef EXCL
#define EXCL -1
#endif
#define PH(n) if ((ONLY < 0 || ONLY == n) && (n >= OLO && n <= OHI) && n != EXCL && ph_lo <= n && n < ph_hi)
#define SY(n) if (ph_lo <= n && n + 1 < ph_hi) xcd_barrier(xb);
  PH(0) {
    gmlp_pre(p, 2, p.in[0], smem);
  }
  SY(0)
  PH(1) {
    gmlp_in_phase(HB, gWin, B1, B2, (float*)B3, smem);
  }
  SY(1)
  PH(2) {
    gmlp_gate_phase(p.in[6], p.in[7], p.in[4], p.in[5], B2, (const float*)B3, B1, smem);
  }
  SY(2)
  PH(3) {
    out_phase(B1, gWout, p.in[0], h, smem);
  }
  SY(3)
  PH(4) {
    convT_phase<MAP_IDENT>(p.in[10], 1024, 4096, 4096, p.in[9], sWin, (float*)smem);
        convT_phase<MAP_IDENT>(p.in[19], 2048, 2048, 2048, nullptr, sWglu, (float*)smem);
        convT_phase<MAP_IDENT>(p.in[21], 2048, 1024, 1024, nullptr, sWout, (float*)smem);
        ssm_pre_phase(p, (float*)smem, sWg, sYg, sLam);
        rownorm_phase(h, HB);
  }
  SY(4)
  PH(5) {
    s5_inu_phase(HB, sWin, B1, smem);
  }
  SY(5)
  PH(6) {
    s5_sgemm_phase(B1, sWg, sLam, B3, smem);
  }
  SY(6)
  PH(8) {
    s5_ygemm_phase(B1, B3, sYg, B2, smem);
  }
  SY(8)
  PH(10) {
    s5_glu_phase(HB, sWin + (size_t)2048 * DM, B2, sWglu, p.in[20], B1, smem);
  }
  SY(10)
  PH(11) {
    out_phase(B1, sWout, h, h, smem);
  }
  SY(11)
  PH(12) {
    convT_phase<MAP_MLA>(p.in[23], 1024, 2624, 2816, p.in[22], mWin, (float*)smem);
        convT_phase<MAP_UV>(p.in[27], 128, 4096, 2048, p.in[26], mWuv, (float*)smem);
        convT_phase<MAP_IDENT>(p.in[28], 2048, 1024, 1024, nullptr, mWout, (float*)smem);
        mla_wq_phase(p.in[25], p.in[27], p.in[24], p.in[26], mWq, (float*)smem);
        rope_table_phase((const int*)p.in[1], mCos, mSin);
        rownorm_phase(h, HB);
  }
  SY(12)
  PH(13) {
    mla_in_phase(HB, mWin, mCq, mQssq, mCkv, mKc, mZ, mCos, mSin, smem);
  }
  SY(13)
  PH(14) {
    mla_q_phase(mCq, mQssq, mWq, mQp, mCos, mSin, mCkv, mKc, mKcT, smem);
  }
  SY(14)
  PH(15) {
    mla_attn_phase(mQp, mKc, mKcT, mWuv, mZ, smem);
  }
  SY(15)
  PH(17) {
    out_phase(mZ, mWout, h, h, smem);
  }
  SY(17)
  PH(18) {
    gmlp_pre(p, 29, h, smem);
  }
  SY(18)
  PH(19) {
    gmlp_in_phase(HB, gWin, B1, B2, (float*)B3, smem);
  }
  SY(19)
  PH(20) {
    gmlp_gate_phase(p.in[33], p.in[34], p.in[31], p.in[32], B2, (const float*)B3, B1, smem);
  }
  SY(20)
  PH(21) {
    out_phase(B1, gWout, h, h, smem);
  }
  SY(21)
  PH(22) {
    finalnorm_phase(h, p.in[36]);
  }
  SY(22)
}

extern "C" void kernel_launch(void* const* d_in, const int* in_sizes, int n_in, void* d_out, int out_size, void* d_ws, size_t ws_size,
                              hipStream_t stream) {
  static int grid_blocks = 0;
  if (!grid_blocks) {
    int dev = 0, cus = 0, per_cu = 0;
    hipGetDevice(&dev);
    hipDeviceGetAttribute(&cus, hipDeviceAttributeMultiprocessorCount, dev);
    hipFuncSetAttribute((const void*)mega_kernel, hipFuncAttributeMaxDynamicSharedMemorySize, SMEM_BYTES);
    hipOccupancyMaxActiveBlocksPerMultiprocessor(&per_cu, (const void*)mega_kernel, NT, SMEM_BYTES);
    if (per_cu > 1) per_cu = 1;
    if (per_cu < 1) per_cu = 1;
    grid_blocks = cus * per_cu;
  }
  Params p{};
  for (int i = 0; i < 37 && i < n_in; ++i) p.in[i] = (const float*)d_in[i];
  p.out = (float*)d_out;
  p.ws = (unsigned char*)d_ws;
  hipMemsetAsync((unsigned char*)d_ws + BAR_OFF, 0, XCD_BAR_WORDS * 4, stream);
  int lo = 0, hi = NPHASE;
  void* args[] = {&p, &lo, &hi};
  hipError_t e = hipLaunchCooperativeKernel((const void*)mega_kernel, dim3(grid_blocks), dim3(NT), args, SMEM_BYTES, stream);
  if (e != hipSuccess) fprintf(stderr, "cooperative launch failed: %s (grid %d)\n", hipGetErrorString(e), grid_blocks);
}
```
